# Optimizing an MI355X kernel written in HIP

```python
import math
import jax, jax.numpy as jnp
from jax import lax
import numpy as np

D_MODEL = 1024
BATCH = 8
SEQ = 2048
DEPTH = 1
DEC_BATCH = 128
DEC_SEQ = 1
PAST_LEN = 16384
PAGE_SIZE = 128

GLA_HEADS = 4
GLA_DK = 64
GLA_DV = 128
GLA_QK = GLA_HEADS * GLA_DK
GLA_V = GLA_HEADS * GLA_DV
GLA_RANK = 16
GLA_GATE_TEMP = 16.0
SSD_HEADS = 8
SSD_HEADDIM = 64
SSD_INNER = SSD_HEADS * SSD_HEADDIM
SSD_GROUPS = 2
SSD_STATE = 64
CONV_W = 4
SSD_CONV_DIM = SSD_INNER + 2 * SSD_GROUPS * SSD_STATE
CHUNK = 64
EPS = 1e-6
PROJ_SIZES = (GLA_QK, GLA_QK, GLA_V, GLA_V, GLA_RANK, SSD_INNER, SSD_CONV_DIM, SSD_HEADS, D_MODEL, D_MODEL)
IN_DIM = sum(PROJ_SIZES)

kernel_name = 'gla_ssd_gated_hybrid_step'


def rmsnorm(x, g):
    xf = x.astype(jnp.float32)
    y = xf * lax.rsqrt(jnp.mean(xf * xf, axis=-1, keepdims=True) + EPS)
    return (y * g.astype(jnp.float32)).astype(x.dtype)


def _split_points(sizes):
    return [int(v) for v in np.cumsum(sizes)[:-1]]


def _chunking(L):
    c = min(CHUNK, L)
    return c, -(-L // c)


def _to_chunks(a, c, n):
    L = a.shape[1]
    a = jnp.pad(a, [(0, 0), (0, n * c - L)] + [(0, 0)] * (a.ndim - 2))
    a = a.reshape(a.shape[0], n, c, *a.shape[2:])
    return jnp.moveaxis(a, 1, 0)


def _from_chunks(a, L):
    a = jnp.moveaxis(a, 0, 1)
    a = a.reshape(a.shape[0], a.shape[1] * a.shape[2], *a.shape[3:])
    return a[:, :L]


def gla_recurrence(q, k, v, log_a, S0):
    L = q.shape[1]
    c, n = _chunking(L)
    mask = jnp.tril(jnp.ones((c, c), dtype=bool))[None, :, :, None, None]

    def step(S, inp):
        qc, kc, vc, ac = inp
        b = jnp.cumsum(ac, axis=1)
        decay = jnp.exp(jnp.where(mask, b[:, :, None] - b[:, None, :], -jnp.inf))
        A = jnp.einsum('bihd,bjhd,bijhd->bhij', qc, kc, decay)
        o = jnp.einsum('bhij,bjhe->bihe', A, vc) + jnp.einsum('bihd,bhde->bihe', qc * jnp.exp(b), S)
        b_last = b[:, -1]
        S_new = jnp.exp(b_last)[..., None] * S + jnp.einsum(
            'bjhd,bjhe->bhde', kc * jnp.exp(b_last[:, None] - b), vc)
        return S_new, o

    xs = tuple(_to_chunks(a, c, n) for a in (q, k, v, log_a))
    S_fin, o = lax.scan(step, S0, xs)
    return _from_chunks(o, L), S_fin


def ssd_recurrence(x, dt, A, Bh, Ch, h0):
    L = x.shape[1]
    c, n = _chunking(L)
    mask = jnp.tril(jnp.ones((c, c), dtype=bool))[None, :, :, None]
    la = dt * A

    def step(h, inp):
        xc, dtc, lac, bc, cc = inp
        cum = jnp.cumsum(lac, axis=1)
        decay = jnp.exp(jnp.where(mask, cum[:, :, None] - cum[:, None, :], -jnp.inf))
        scores = jnp.einsum('bihn,bjhn->bijh', cc, bc) * decay
        xdt = xc * dtc[..., None]
        y = jnp.einsum('bijh,bjhp->bihp', scores, xdt) + jnp.einsum(
            'bihn,bhpn->bihp', cc * jnp.exp(cum)[..., None], h)
        c_last = cum[:, -1]
        h_new = jnp.exp(c_last)[:, :, None, None] * h + jnp.einsum(
            'bjhp,bjhn->bhpn', xdt * jnp.exp(c_last[:, None] - cum)[..., None], bc)
        return h_new, y

    xs = tuple(_to_chunks(a, c, n) for a in (x, dt, la, Bh, Ch))
    h_fin, y = lax.scan(step, h0, xs)
    return _from_chunks(y, L), h_fin


def causal_conv(u, buf, w, bias):
    full = jnp.concatenate([buf.astype(u.dtype), u], axis=1)
    out = lax.conv_general_dilated(full, w[:, None, :].astype(u.dtype), window_strides=(1,), padding='VALID',
                                   dimension_numbers=('NWC', 'WIO', 'NWC'), feature_group_count=u.shape[-1])
    return out + bias.astype(u.dtype), full[:, -(CONV_W - 1):]


def mixer_layer(x, S0, h0, buf, norm_g, w_in, w_a2, b_a2, gla_norm_g, conv_w, conv_b, dt_bias, a_log,
                d_skip, ssd_norm_g, w_br_gla, w_br_ssd, w_out):
    f32 = jnp.float32
    Bsz, L, _ = x.shape
    hn = rmsnorm(x, norm_g)
    proj = hn @ w_in
    q, k, v, g, a_lr, z, xbc, dt_raw, gate_a, gate_b = jnp.split(proj, _split_points(PROJ_SIZES), axis=-1)

    qh = q.reshape(Bsz, L, GLA_HEADS, GLA_DK).astype(f32) * (GLA_DK ** -0.5)
    kh = k.reshape(Bsz, L, GLA_HEADS, GLA_DK).astype(f32)
    vh = v.reshape(Bsz, L, GLA_HEADS, GLA_DV).astype(f32)
    log_a = (jax.nn.log_sigmoid((a_lr @ w_a2 + b_a2).astype(f32)) / GLA_GATE_TEMP).reshape(Bsz, L, GLA_HEADS, GLA_DK)
    o, S_new = gla_recurrence(qh, kh, vh, log_a, S0.astype(f32))
    o = rmsnorm(o, gla_norm_g.reshape(GLA_HEADS, GLA_DV)).reshape(Bsz, L, GLA_V)
    o = (o * jax.nn.silu(g.astype(f32))).astype(x.dtype)

    xbc_c, buf_new = causal_conv(xbc, buf, conv_w, conv_b)
    xbc_c = jax.nn.silu(xbc_c.astype(f32))
    xs, Bm, Cm = jnp.split(xbc_c, [SSD_INNER, SSD_INNER + SSD_GROUPS * SSD_STATE], axis=-1)
    dt = jax.nn.softplus(dt_raw.astype(f32) + dt_bias.astype(f32))
    A = -jnp.exp(a_log.astype(f32))
    xs_h = xs.reshape(Bsz, L, SSD_HEADS, SSD_HEADDIM)
    rep = SSD_HEADS // SSD_GROUPS
    Bh = jnp.repeat(Bm.reshape(Bsz, L, SSD_GROUPS, SSD_STATE), rep, axis=2)
    Ch = jnp.repeat(Cm.reshape(Bsz, L, SSD_GROUPS, SSD_STATE), rep, axis=2)
    y, h_new = ssd_recurrence(xs_h, dt, A, Bh, Ch, h0.astype(f32))
    y = y + d_skip.astype(f32)[:, None] * xs_h
    y = y.reshape(Bsz, L, SSD_INNER) * jax.nn.silu(z.astype(f32))
    y = rmsnorm(y.reshape(Bsz, L, SSD_GROUPS, SSD_INNER // SSD_GROUPS),
                ssd_norm_g.reshape(SSD_GROUPS, SSD_INNER // SSD_GROUPS)).reshape(Bsz, L, SSD_INNER).astype(x.dtype)

    merged = jax.nn.sigmoid(gate_a) * (o @ w_br_gla) + jax.nn.sigmoid(gate_b) * (y @ w_br_ssd)
    out = x + merged @ w_out
    return out, S_new.astype(x.dtype), h_new.astype(x.dtype), buf_new.astype(x.dtype)


def trunk(x, s_gla, s_ssm, s_conv, params, final_norm_g):
    new_g, new_s, new_c = [], [], []
    for l in range(DEPTH):
        x, sg, ss, sc = mixer_layer(x, s_gla[l], s_ssm[l], s_conv[l], *[p[l] for p in params])
        new_g.append(sg)
        new_s.append(ss)
        new_c.append(sc)
    return rmsnorm(x, final_norm_g), jnp.stack(new_g), jnp.stack(new_s), jnp.stack(new_c)


def setup_inputs(seed: int = 0) -> dict:
    key = jax.random.key(seed)
    ks = jax.random.split(key, 20)
    f = jnp.float32

    def nrm(k, shape, s):
        return jax.random.normal(k, shape, f) * s

    dt0 = jnp.exp(jax.random.uniform(ks[12], (DEPTH, SSD_HEADS), f, math.log(1e-3), math.log(1e-1)))
    return {
        'x_prompt': nrm(ks[0], (BATCH, SEQ, D_MODEL), 1.0),
        'x_sample': nrm(ks[1], (DEC_BATCH, DEC_SEQ, D_MODEL), 1.0),
        'state_gla': nrm(ks[2], (DEPTH, DEC_BATCH, GLA_HEADS, GLA_DK, GLA_DV), 1.0),
        'state_ssm': nrm(ks[3], (DEPTH, DEC_BATCH, SSD_HEADS, SSD_HEADDIM, SSD_STATE), 0.5),
        'state_conv': nrm(ks[4], (DEPTH, DEC_BATCH, CONV_W - 1, SSD_CONV_DIM), 1.0),
        'norm_g': 1.0 + nrm(ks[5], (DEPTH, D_MODEL), 0.02),
        'w_in': nrm(ks[6], (DEPTH, D_MODEL, IN_DIM), D_MODEL ** -0.5),
        'w_a2': nrm(ks[7], (DEPTH, GLA_RANK, GLA_QK), GLA_RANK ** -0.5),
        'b_a2': nrm(ks[8], (DEPTH, GLA_QK), 0.1),
        'gla_norm_g': 1.0 + nrm(ks[9], (DEPTH, GLA_V), 0.02),
        'conv_w': nrm(ks[10], (DEPTH, CONV_W, SSD_CONV_DIM), CONV_W ** -0.5),
        'conv_b': nrm(ks[11], (DEPTH, SSD_CONV_DIM), 0.01),
        'dt_bias': dt0 + jnp.log(-jnp.expm1(-dt0)),
        'a_log': jnp.log(jax.random.uniform(ks[13], (DEPTH, SSD_HEADS), f, 1.0, 16.0)),
        'd_skip': 1.0 + nrm(ks[14], (DEPTH, SSD_HEADS), 0.1),
        'ssd_norm_g': 1.0 + nrm(ks[15], (DEPTH, SSD_INNER), 0.02),
        'w_br_gla': nrm(ks[16], (DEPTH, GLA_V, D_MODEL), GLA_V ** -0.5),
        'w_br_ssd': nrm(ks[17], (DEPTH, SSD_INNER, D_MODEL), SSD_INNER ** -0.5),
        'w_out': nrm(ks[18], (DEPTH, D_MODEL, D_MODEL), D_MODEL ** -0.5),
        'final_norm_g': 1.0 + nrm(ks[19], (D_MODEL,), 0.02),
    }


def reference(x_prompt, x_sample, state_gla, state_ssm, state_conv, norm_g, w_in, w_a2, b_a2, gla_norm_g,
              conv_w, conv_b, dt_bias, a_log, d_skip, ssd_norm_g, w_br_gla, w_br_ssd, w_out, final_norm_g):
    params = (norm_g, w_in, w_a2, b_a2, gla_norm_g, conv_w, conv_b, dt_bias, a_log, d_skip, ssd_norm_g,
              w_br_gla, w_br_ssd, w_out)
    bp = x_prompt.shape[0]
    dtp = x_prompt.dtype
    zero_gla = jnp.zeros((DEPTH, bp, GLA_HEADS, GLA_DK, GLA_DV), dtp)
    zero_ssm = jnp.zeros((DEPTH, bp, SSD_HEADS, SSD_HEADDIM, SSD_STATE), dtp)
    zero_conv = jnp.zeros((DEPTH, bp, CONV_W - 1, SSD_CONV_DIM), dtp)
    y_prompt, gla_p, ssm_p, conv_p = trunk(x_prompt, zero_gla, zero_ssm, zero_conv, params, final_norm_g)
    y_sample, gla_s, ssm_s, conv_s = trunk(x_sample, state_gla, state_ssm, state_conv, params, final_norm_g)
    return (y_prompt, y_sample, gla_p, ssm_p, conv_p, gla_s, ssm_s, conv_s)
```

```cpp
#include <hip/hip_runtime.h>
#include <hip/hip_cooperative_groups.h>
#include <cstdio>
namespace cg = cooperative_groups;

#ifndef MK_MULTI
#define MK_MULTI 1
#endif

typedef unsigned short u16;
typedef __attribute__((ext_vector_type(8))) short bf16x8;
typedef __attribute__((ext_vector_type(16))) float f32x16;
typedef __attribute__((ext_vector_type(4))) unsigned u32x4;
#define DI __device__ __forceinline__
#define MFMA(a, b, c) __builtin_amdgcn_mfma_f32_32x32x16_bf16((a), (b), (c), 0, 0, 0)

constexpr int T_ALL = 16512, T_P = 16384, NP = 4992;
constexpr int CQ = 0, CK = 256, CV = 512, CG = 1024, CZ = 1536, CX = 2048, CGA = 2816, CGB = 3840, CAL = 4864, CDT = 4880;
constexpr size_t OFF_PROJ = 0;
constexpr size_t OFF_WIN = 164855808;
constexpr size_t OFF_WG = 175079424;
constexpr size_t OFF_WS = 176128000;
constexpr size_t OFF_WO = 177176576;
constexpr size_t OFF_X1 = 179273728;
constexpr size_t OFF_X2 = 213090304;
constexpr size_t OFF_DT = 246906880;
constexpr size_t OFF_CUM = 247431168;
constexpr size_t OFF_GG = 247955456;
constexpr size_t OFF_GS = 248217600;
constexpr size_t WS_NEED = 248225792;
constexpr size_t O_YS = 16777216, O_GLAP = 16908288, O_SSMP = 17170432, O_CONVP = 17432576, O_GLAS = 17451008, O_SSMS = 21645312, O_CONVS = 25839616;
constexpr size_t OUTB_HN = 0, OUTB_XBCC = 33816576;

struct Params {
  const float *x_p, *x_s, *st_gla, *st_ssm, *st_conv, *norm_g, *w_in, *w_a2, *b_a2, *gla_ng, *conv_w, *conv_b, *dt_bias, *a_log,
      *d_skip, *ssd_ng, *w_brg, *w_brs, *w_out, *fin_g;
  float* out;
  char* ws;
  int ph_lo, ph_hi;
};

DI u16 f2bf(float x) { unsigned u = __float_as_uint(x); u += 0x7fffu + ((u >> 16) & 1u); return (u16)(u >> 16); }
DI float bf2f(u16 v) { return __uint_as_float(((unsigned)v) << 16); }
DI unsigned pack2(float a, float b) { return (unsigned)f2bf(a) | ((unsigned)f2bf(b) << 16); }
DI float bflo(unsigned u) { return __uint_as_float(u << 16); }
DI float bfhi(unsigned u) { return __uint_as_float(u & 0xffff0000u); }
DI int crow(int r, int h) { return (r & 3) + 8 * (r >> 2) + 4 * h; }
DI int img_off(int row, int k) { return row * 128 + ((((k >> 3) ^ (row >> 1)) & 7) << 4) + ((k & 7) << 1); }
DI int chunk_off(int row, int chunk) { return row * 128 + (((chunk ^ (row >> 1)) & 7) << 4); }
DI bf16x8 frag(const char* img, int row0, int ks, int lane) {
  int row = row0 + (lane & 31);
  return *(const bf16x8*)(img + chunk_off(row, ks * 2 + (lane >> 5)));
}
DI void mma64(f32x16& acc, const char* ia, int ra, const char* ib, int rb, int lane) {
#pragma unroll
  for (int ks = 0; ks < 4; ++ks) acc = MFMA(frag(ia, ra, ks, lane), frag(ib, rb, ks, lane), acc);
}
DI float sigm(float x) { return __builtin_amdgcn_rcpf(1.f + __expf(-x)); }
DI float silu(float x) { return x * __builtin_amdgcn_rcpf(1.f + __expf(-x)); }
DI float softplus(float x) { return fmaxf(x, 0.f) + log1pf(expf(-fabsf(x))); }
DI float logsig(float x) { return fminf(x, 0.f) - log1pf(expf(-fabsf(x))); }
DI float red32(float v) {
#pragma unroll
  for (int o = 16; o > 0; o >>= 1) v += __shfl_xor(v, o);
  return v;
}
DI float red64(float v) {
#pragma unroll
  for (int o = 32; o > 0; o >>= 1) v += __shfl_xor(v, o);
  return v;
}
DI f32x16 zero16() { f32x16 z; for (int i = 0; i < 16; ++i) z[i] = 0.f; return z; }

DI void transpose_tile(const float* __restrict__ src, int src_ld, int K, u16* __restrict__ dst, int n0, int k0, int mapcols, char* smem) {
  float* tile = (float*)smem;
  const int t = threadIdx.x, lane = t & 63, w = t >> 6;
  int n = n0 + lane, col;
  if (mapcols) {
    if (n < 1536) col = n; else if (n < 2816) col = n + 16; else if (n < 4864) col = n + 24;
    else if (n < 4880) col = 1536 + (n - 4864); else if (n < 4888) col = 2832 + (n - 4880); else col = -1;
  } else col = n;
#pragma unroll 4
  for (int r = 0; r < 16; ++r) {
    int kk = r * 4 + w;
    tile[kk * 65 + lane] = col >= 0 ? src[(size_t)(k0 + kk) * src_ld + col] : 0.f;
  }
  __syncthreads();
  {
    int nn = t >> 2, kq = t & 3;
    unsigned pk[8];
#pragma unroll
    for (int i = 0; i < 8; ++i) pk[i] = pack2(tile[(kq * 16 + 2 * i) * 65 + nn], tile[(kq * 16 + 2 * i + 1) * 65 + nn]);
    u32x4* d = (u32x4*)(dst + (size_t)(n0 + nn) * K + k0 + kq * 16);
    u32x4 a, b;
    a[0] = pk[0]; a[1] = pk[1]; a[2] = pk[2]; a[3] = pk[3]; b[0] = pk[4]; b[1] = pk[5]; b[2] = pk[6]; b[3] = pk[7];
    d[0] = a; d[1] = b;
  }
  __syncthreads();
}

DI void p0_item(const Params& p, int item, char* smem) {
  const int t = threadIdx.x, lane = t & 63, w = t >> 6;
  if (item < 4128) {
    int row = item * 4 + w;
    const float* xr = row < T_P ? p.x_p + (size_t)row * 1024 : p.x_s + (size_t)(row - T_P) * 1024;
    float4 v[4];
    float ss = 0.f;
#pragma unroll
    for (int i = 0; i < 4; ++i) { v[i] = ((const float4*)xr)[lane + 64 * i]; ss += v[i].x * v[i].x + v[i].y * v[i].y + v[i].z * v[i].z + v[i].w * v[i].w; }
    ss = red64(ss);
    float rs = rsqrtf(ss * (1.f / 1024.f) + 1e-6f);
    u16* hn = (u16*)((char*)p.out + OUTB_HN) + (size_t)row * 1024;
#pragma unroll
    for (int i = 0; i < 4; ++i) {
      float4 g = ((const float4*)p.norm_g)[lane + 64 * i];
      uint2 o;
      o.x = pack2(v[i].x * rs * g.x, v[i].y * rs * g.y);
      o.y = pack2(v[i].z * rs * g.z, v[i].w * rs * g.w);
      *(uint2*)(hn + (lane + 64 * i) * 4) = o;
    }
  } else {
    int idx = item - 4128;
    if (idx < 1248) transpose_tile(p.w_in, 4888, 1024, (u16*)(p.ws + OFF_WIN), (idx >> 4) * 64, (idx & 15) * 64, 1, smem);
    else if (idx < 1376) { idx -= 1248; transpose_tile(p.w_brg, 1024, 512, (u16*)(p.ws + OFF_WG), (idx >> 3) * 64, (idx & 7) * 64, 0, smem); }
    else if (idx < 1504) { idx -= 1376; transpose_tile(p.w_brs, 1024, 512, (u16*)(p.ws + OFF_WS), (idx >> 3) * 64, (idx & 7) * 64, 0, smem); }
    else { idx -= 1504; transpose_tile(p.w_out, 1024, 1024, (u16*)(p.ws + OFF_WO), (idx >> 4) * 64, (idx & 15) * 64, 0, smem); }
  }
}

DI void gemm_core(const u16* __restrict__ A, int lda, const u16* __restrict__ B, int ldb, int nk, char* smem, f32x16 (&acc)[2][2]) {
  const int t = threadIdx.x, lane = t & 63, w = t >> 6, wm = w >> 1, wn = w & 1;
  const int lr = t >> 3, lc = t & 7;
  const int soff = lr * 128 + (((lc ^ (lr >> 1)) & 7) << 4);
  const u16* ap = A + (size_t)lr * lda + lc * 8;
  const u16* bp = B + (size_t)lr * ldb + lc * 8;
  u32x4 ra[4], rb[4];
#pragma unroll
  for (int i = 0; i < 4; ++i) { ra[i] = *(const u32x4*)(ap + (size_t)(32 * i) * lda); rb[i] = *(const u32x4*)(bp + (size_t)(32 * i) * ldb); }
#pragma unroll
  for (int i = 0; i < 4; ++i) { *(u32x4*)(smem + soff + i * 4096) = ra[i]; *(u32x4*)(smem + 16384 + soff + i * 4096) = rb[i]; }
  __syncthreads();
  for (int kt = 0; kt < nk; ++kt) {
    const bool more = kt + 1 < nk;
    if (more) {
#pragma unroll
      for (int i = 0; i < 4; ++i) { ra[i] = *(const u32x4*)(ap + (size_t)(32 * i) * lda + (kt + 1) * 64); rb[i] = *(const u32x4*)(bp + (size_t)(32 * i) * ldb + (kt + 1) * 64); }
    }
    const char* sa = smem + (kt & 1) * 32768;
    const char* sb = sa + 16384;
#pragma unroll
    for (int ks = 0; ks < 4; ++ks) {
      bf16x8 a0 = frag(sa, wm * 64, ks, lane), a1 = frag(sa, wm * 64 + 32, ks, lane);
      bf16x8 b0 = frag(sb, wn * 64, ks, lane), b1 = frag(sb, wn * 64 + 32, ks, lane);
      acc[0][0] = MFMA(a0, b0, acc[0][0]); acc[0][1] = MFMA(a0, b1, acc[0][1]);
      acc[1][0] = MFMA(a1, b0, acc[1][0]); acc[1][1] = MFMA(a1, b1, acc[1][1]);
    }
    if (more) {
      char* da = smem + ((kt + 1) & 1) * 32768;
#pragma unroll
      for (int i = 0; i < 4; ++i) { *(u32x4*)(da + soff + i * 4096) = ra[i]; *(u32x4*)(da + 16384 + soff + i * 4096) = rb[i]; }
    }
    __syncthreads();
  }
}

DI void acc_to_lds(const f32x16 (&acc)[2][2], float* T) {
  const int lane = threadIdx.x & 63, w = threadIdx.x >> 6, wm = w >> 1, wn = w & 1, h = lane >> 5;
  float* base = T + (wm * 64 + 4 * h) * 128 + wn * 64 + (lane & 31);
#pragma unroll
  for (int i = 0; i < 2; ++i)
#pragma unroll
    for (int j = 0; j < 2; ++j)
#pragma unroll
      for (int r2 = 0; r2 < 16; ++r2) base[(i * 32 + (r2 & 3) + 8 * (r2 >> 2)) * 128 + j * 32] = acc[i][j][r2];
}

DI void p1_tile(const Params& p, int tile, char* smem) {
  int g = tile / 624, r = tile - g * 624, gsz = min(16, 129 - g * 16);
  int m0 = (g * 16 + r % gsz) * 128, n0 = (r / gsz) * 128;
  const u16* hn = (const u16*)((const char*)p.out + OUTB_HN);
  f32x16 acc[2][2];
  for (int i = 0; i < 2; ++i) for (int j = 0; j < 2; ++j) acc[i][j] = zero16();
  gemm_core(hn + (size_t)m0 * 1024, 1024, (const u16*)(p.ws + OFF_WIN) + (size_t)n0 * 1024, 1024, 16, smem, acc);
  const int lane = threadIdx.x & 63, w = threadIdx.x >> 6;
  float* T = (float*)smem;
  acc_to_lds(acc, T);
  __syncthreads();
  u16* proj = (u16*)(p.ws + OFF_PROJ) + (size_t)m0 * NP + n0 + lane * 2;
#pragma unroll 4
  for (int rr = 0; rr < 32; ++rr) {
    int row = w * 32 + rr;
    float2 v = *(const float2*)(T + row * 128 + lane * 2);
    *(unsigned*)(proj + (size_t)row * NP) = pack2(v.x, v.y);
  }
  __syncthreads();
}

DI void p3_tile(const Params& p, int tile, char* smem) {
  int m0 = (tile >> 3) * 128, n0 = (tile & 7) * 128;
  const u16* U = (const u16*)(p.ws + OFF_X1);
  const int lane = threadIdx.x & 63, w = threadIdx.x >> 6;
  const u16* gate = (const u16*)(p.ws + OFF_PROJ) + (size_t)m0 * NP + n0 + lane * 2;
  u16* mg = (u16*)(p.ws + OFF_X2) + (size_t)m0 * 1024 + n0 + lane * 2;
  float* T = (float*)smem;
  f32x16 acc[2][2];
  for (int i = 0; i < 2; ++i) for (int j = 0; j < 2; ++j) acc[i][j] = zero16();
  gemm_core(U + (size_t)m0 * 1024, 1024, (const u16*)(p.ws + OFF_WG) + (size_t)n0 * 512, 512, 8, smem, acc);
  acc_to_lds(acc, T);
  __syncthreads();
#pragma unroll 4
  for (int rr = 0; rr < 32; ++rr) {
    int row = w * 32 + rr;
    float2 v = *(const float2*)(T + row * 128 + lane * 2);
    unsigned ga = *(const unsigned*)(gate + (size_t)row * NP + CGA);
    *(unsigned*)(mg + (size_t)row * 1024) = pack2(v.x * sigm(bflo(ga)), v.y * sigm(bfhi(ga)));
  }
  __syncthreads();
  for (int i = 0; i < 2; ++i) for (int j = 0; j < 2; ++j) acc[i][j] = zero16();
  gemm_core(U + (size_t)m0 * 1024 + 512, 1024, (const u16*)(p.ws + OFF_WS) + (size_t)n0 * 512, 512, 8, smem, acc);
  acc_to_lds(acc, T);
  __syncthreads();
#pragma unroll 4
  for (int rr = 0; rr < 32; ++rr) {
    int row = w * 32 + rr;
    float2 v = *(const float2*)(T + row * 128 + lane * 2);
    unsigned gb = *(const unsigned*)(gate + (size_t)row * NP + CGB);
    unsigned m1 = *(const unsigned*)(mg + (size_t)row * 1024);
    *(unsigned*)(mg + (size_t)row * 1024) = pack2(bflo(m1) + v.x * sigm(bflo(gb)), bfhi(m1) + v.y * sigm(bfhi(gb)));
  }
  __syncthreads();
}

DI void p4_tile(const Params& p, int tile, char* smem) {
  int m0 = (tile >> 3) * 128, n0 = (tile & 7) * 128;
  const u16* mg = (const u16*)(p.ws + OFF_X2);
  const int lane = threadIdx.x & 63, w = threadIdx.x >> 6;
  float* T = (float*)smem;
  f32x16 acc[2][2];
  for (int i = 0; i < 2; ++i) for (int j = 0; j < 2; ++j) acc[i][j] = zero16();
  gemm_core(mg + (size_t)m0 * 1024, 1024, (const u16*)(p.ws + OFF_WO) + (size_t)n0 * 1024, 1024, 16, smem, acc);
  acc_to_lds(acc, T);
  __syncthreads();
#pragma unroll 4
  for (int rr = 0; rr < 32; ++rr) {
    int row = m0 + w * 32 + rr;
    float2 v = *(const float2*)(T + (w * 32 + rr) * 128 + lane * 2);
    const float* xr = row < T_P ? p.x_p + (size_t)row * 1024 : p.x_s + (size_t)(row - T_P) * 1024;
    float2 xv = *(const float2*)(xr + n0 + lane * 2);
    float2 o; o.x = xv.x + v.x; o.y = xv.y + v.y;
    *(float2*)(p.out + (size_t)row * 1024 + n0 + lane * 2) = o;
  }
  __syncthreads();
}

DI void p5_item(const Params& p, int item) {
  const int lane = threadIdx.x & 63, w = threadIdx.x >> 6;
  int row = item * 4 + w;
  float4* o = (float4*)(p.out + (size_t)row * 1024);
  float4 v[4];
  float ss = 0.f;
#pragma unroll
  for (int i = 0; i < 4; ++i) { v[i] = o[lane + 64 * i]; ss += v[i].x * v[i].x + v[i].y * v[i].y + v[i].z * v[i].z + v[i].w * v[i].w; }
  ss = red64(ss);
  float rs = rsqrtf(ss * (1.f / 1024.f) + 1e-6f);
#pragma unroll
  for (int i = 0; i < 4; ++i) {
    float4 g = ((const float4*)p.fin_g)[lane + 64 * i];
    float4 r; r.x = v[i].x * rs * g.x; r.y = v[i].y * rs * g.y; r.z = v[i].z * rs * g.z; r.w = v[i].w * rs * g.w;
    o[lane + 64 * i] = r;
  }
}

DI void build_vt(const u16* proj, int tok0, int colbase, char* VT) {
  const int t = threadIdx.x, e = t & 127, half = t >> 7;
#pragma unroll
  for (int cc = 0; cc < 4; ++cc) {
    int ch = half * 4 + cc;
    unsigned pk[4];
#pragma unroll
    for (int q = 0; q < 4; ++q) {
      unsigned lo = proj[(size_t)(tok0 + ch * 8 + 2 * q) * NP + colbase + e];
      unsigned hi = proj[(size_t)(tok0 + ch * 8 + 2 * q + 1) * NP + colbase + e];
      pk[q] = lo | (hi << 16);
    }
    u32x4 v; v[0] = pk[0]; v[1] = pk[1]; v[2] = pk[2]; v[3] = pk[3];
    *(u32x4*)(VT + chunk_off(e, ch)) = v;
  }
}

DI void p2a_gla(const Params& p, int item, char* smem) {
  const int h = item & 3, c = (item >> 2) & 31, b = item >> 7;
  const int t = threadIdx.x, lane = t & 63, w = t >> 6, d = t & 63, tg = w;
  const int tok0 = b * 2048 + c * 64;
  u16* proj = (u16*)(p.ws + OFF_PROJ);
  char* KT = smem;
  char* VT = smem + 8192;
  float* tot_s = (float*)(smem + 24576);
  float wa[16];
#pragma unroll
  for (int r = 0; r < 16; ++r) wa[r] = p.w_a2[r * 256 + h * 64 + d];
  const float bias = p.b_a2[h * 64 + d];
  float bl[16];
  float run = 0.f;
#pragma unroll
  for (int jj = 0; jj < 16; ++jj) {
    const u16* al = proj + (size_t)(tok0 + tg * 16 + jj) * NP + CAL;
    u32x4 a0 = *(const u32x4*)al, a1 = *(const u32x4*)(al + 8);
    float x = bias;
#pragma unroll
    for (int q = 0; q < 4; ++q) {
      x += bflo(a0[q]) * wa[2 * q] + bfhi(a0[q]) * wa[2 * q + 1];
      x += bflo(a1[q]) * wa[8 + 2 * q] + bfhi(a1[q]) * wa[8 + 2 * q + 1];
    }
    run += logsig(x) * (1.f / 16.f);
    bl[jj] = run;
  }
  tot_s[tg * 64 + d] = run;
  __syncthreads();
  float off = 0.f;
#pragma unroll
  for (int g = 0; g < 4; ++g) off += (g < tg) ? tot_s[g * 64 + d] : 0.f;
  unsigned kpk[8];
#pragma unroll
  for (int jj = 0; jj < 16; jj += 2) {
    unsigned kk2[2];
#pragma unroll
    for (int u = 0; u < 2; ++u) {
      size_t base = (size_t)(tok0 + tg * 16 + jj + u) * NP + h * 64 + d;
      float bb = bl[jj + u] + off;
      float qv = bf2f(proj[base + CQ]), kv = bf2f(proj[base + CK]);
      float eb = expf(bb);
      proj[base + CQ] = f2bf(qv * 0.125f * eb);
      u16 kb = f2bf(kv * expf(-bb));
      proj[base + CK] = kb;
      kk2[u] = kb;
    }
    kpk[jj >> 1] = kk2[0] | (kk2[1] << 16);
  }
  {
    u32x4 v0, v1;
    v0[0] = kpk[0]; v0[1] = kpk[1]; v0[2] = kpk[2]; v0[3] = kpk[3];
    v1[0] = kpk[4]; v1[1] = kpk[5]; v1[2] = kpk[6]; v1[3] = kpk[7];
    *(u32x4*)(KT + chunk_off(d, tg * 2)) = v0;
    *(u32x4*)(KT + chunk_off(d, tg * 2 + 1)) = v1;
  }
  build_vt(proj, tok0, CV + h * 128, VT);
  __syncthreads();
  const int dcol = lane & 31, hh = lane >> 5;
  float* gdec = (float*)(p.ws + OFF_GG) + (size_t)((b * 32 + c) * 4 + h) * 64;
  u16* dS = (u16*)(p.ws + OFF_X1) + (size_t)((b * 32 + c) * 4 + h) * 8192;
#pragma unroll
  for (int dt = 0; dt < 2; ++dt) {
    f32x16 acc = zero16();
    mma64(acc, VT, w * 32, KT, dt * 32, lane);
    int dd = dt * 32 + dcol;
    float gd = expf(tot_s[dd] + tot_s[64 + dd] + tot_s[128 + dd] + tot_s[192 + dd]);
    if (w == 0 && hh == 0) gdec[dd] = gd;
#pragma unroll
    for (int r = 0; r < 16; ++r) {
      int e = w * 32 + crow(r, hh);
      dS[e * 64 + dd] = f2bf(acc[r] * gd);
    }
  }
  __syncthreads();
}

DI void conv_channel(const Params& p, const u16* proj, u16* xbcc, int tok0, int c, int ch, char* img, int row, const float* sc) {
  float cw0 = p.conv_w[ch], cw1 = p.conv_w[768 + ch], cw2 = p.conv_w[1536 + ch], cw3 = p.conv_w[2304 + ch], cb = p.conv_b[ch];
  float x3 = 0.f, x2 = 0.f, x1 = 0.f;
  if (c > 0) {
    x3 = bf2f(proj[(size_t)(tok0 - 3) * NP + CX + ch]);
    x2 = bf2f(proj[(size_t)(tok0 - 2) * NP + CX + ch]);
    x1 = bf2f(proj[(size_t)(tok0 - 1) * NP + CX + ch]);
  }
#pragma unroll 2
  for (int cc = 0; cc < 8; ++cc) {
    unsigned pk[4];
#pragma unroll
    for (int q = 0; q < 4; ++q) {
      unsigned two[2];
#pragma unroll
      for (int u = 0; u < 2; ++u) {
        int j = cc * 8 + q * 2 + u;
        float xn = bf2f(proj[(size_t)(tok0 + j) * NP + CX + ch]);
        float s = cb + x3 * cw0 + x2 * cw1 + x1 * cw2 + xn * cw3;
        float y = silu(s);
        u16 yb = f2bf(y);
        xbcc[(size_t)(tok0 + j) * 768 + ch] = yb;
        two[u] = sc ? (unsigned)f2bf(bf2f(yb) * sc[j]) : (unsigned)yb;
        x3 = x2; x2 = x1; x1 = xn;
      }
      pk[q] = two[0] | (two[1] << 16);
    }
    if (img) { u32x4 v; v[0] = pk[0]; v[1] = pk[1]; v[2] = pk[2]; v[3] = pk[3]; *(u32x4*)(img + chunk_off(row, cc)) = v; }
  }
}

DI void p2a_ssd(const Params& p, int item, char* smem) {
  const int grp = item & 1, c = (item >> 1) & 31, b = item >> 6;
  const int t = threadIdx.x, lane = t & 63, w = t >> 6;
  const int tok0 = b * 2048 + c * 64;
  const u16* proj = (const u16*)(p.ws + OFF_PROJ);
  u16* xbcc = (u16*)((char*)p.out + OUTB_XBCC);
  char* XT = smem;
  char* BT = smem + 32768;
  float* sc_s = (float*)(smem + 40960);
  {
    int hd = grp * 4 + w, tok = tok0 + lane;
    float dt = softplus(bf2f(proj[(size_t)tok * NP + CDT + hd]) + p.dt_bias[hd]);
    float la = -expf(p.a_log[hd]) * dt;
    float cum = la;
#pragma unroll
    for (int o = 1; o < 64; o <<= 1) { float n = __shfl_up(cum, o); if (lane >= o) cum += n; }
    float clast = __shfl(cum, 63);
    ((float*)(p.ws + OFF_DT))[(size_t)tok * 8 + hd] = dt;
    ((float*)(p.ws + OFF_CUM))[(size_t)tok * 8 + hd] = cum;
    sc_s[w * 64 + lane] = dt * expf(clast - cum);
    if (lane == 63) ((float*)(p.ws + OFF_GS))[(b * 32 + c) * 8 + hd] = expf(clast);
  }
  __syncthreads();
  conv_channel(p, proj, xbcc, tok0, c, grp * 256 + t, XT, t, sc_s + (t >> 6) * 64);
  if (t < 64) conv_channel(p, proj, xbcc, tok0, c, 512 + grp * 64 + t, BT, t, nullptr);
  else if (t < 128) conv_channel(p, proj, xbcc, tok0, c, 640 + grp * 64 + (t - 64), nullptr, 0, nullptr);
  __syncthreads();
  {
    const int hd = grp * 4 + w, hh = lane >> 5;
    u16* dh = (u16*)(p.ws + OFF_X1 + 16777216) + (size_t)((b * 32 + c) * 8 + hd) * 4096;
#pragma unroll
    for (int pt = 0; pt < 2; ++pt)
#pragma unroll
      for (int nt = 0; nt < 2; ++nt) {
        f32x16 acc = zero16();
        mma64(acc, XT, w * 64 + pt * 32, BT, nt * 32, lane);
#pragma unroll
        for (int r = 0; r < 16; ++r) dh[(pt * 32 + crow(r, hh)) * 64 + nt * 32 + (lane & 31)] = f2bf(acc[r]);
      }
  }
  if (c == 31) {
    for (int i = t; i < 3 * 384; i += 256) {
      int r = i / 384, q = i - r * 384;
      int ch = q < 256 ? grp * 256 + q : (q < 320 ? 512 + grp * 64 + (q - 256) : 640 + grp * 64 + (q - 320));
      p.out[O_CONVP + (size_t)(b * 3 + r) * 768 + ch] = bf2f(proj[(size_t)(b * 2048 + 2045 + r) * NP + CX + ch]);
    }
  }
  __syncthreads();
}

DI void p2a_gla_sample(const Params& p, int item, char* smem) {
  const int h = item & 3, s = item >> 2, tok = T_P + s;
  const int t = threadIdx.x, lane = t & 63, w = t >> 6;
  const u16* proj = (const u16*)(p.ws + OFF_PROJ) + (size_t)tok * NP;
  float* g_s = (float*)smem;
  float* q_s = g_s + 64;
  float* k_s = q_s + 64;
  float* v_s = k_s + 64;
  float* op_s = v_s + 128;
  float* red_s = op_s + 256;
  if (t < 64) {
    float x = p.b_a2[h * 64 + t];
#pragma unroll
    for (int r = 0; r < 16; ++r) x += bf2f(proj[CAL + r]) * p.w_a2[r * 256 + h * 64 + t];
    g_s[t] = expf(logsig(x) * (1.f / 16.f));
    q_s[t] = bf2f(proj[CQ + h * 64 + t]) * 0.125f;
    k_s[t] = bf2f(proj[CK + h * 64 + t]);
  } else if (t < 192) v_s[t - 64] = bf2f(proj[CV + h * 128 + (t - 64)]);
  __syncthreads();
  const int e = t & 127, dh = t >> 7;
  const float* S0 = p.st_gla + (size_t)(s * 4 + h) * 8192;
  float* So = p.out + O_GLAS + (size_t)(s * 4 + h) * 8192;
  float ve = v_s[e], op = 0.f;
#pragma unroll 8
  for (int dd = 0; dd < 32; ++dd) {
    int d = dh * 32 + dd;
    float sn = g_s[d] * S0[d * 128 + e] + k_s[d] * ve;
    So[d * 128 + e] = sn;
    op += q_s[d] * sn;
  }
  op_s[dh * 128 + e] = op;
  __syncthreads();
  float o = 0.f;
  if (t < 128) o = op_s[t] + op_s[128 + t];
  float ss = red64(o * o);
  if (lane == 0) red_s[w] = ss;
  __syncthreads();
  if (t < 128) {
    float rs = rsqrtf((red_s[0] + red_s[1]) * (1.f / 128.f) + 1e-6f);
    float gg = bf2f(proj[CG + h * 128 + t]);
    u16* U = (u16*)(p.ws + OFF_X1) + (size_t)tok * 1024;
    U[h * 128 + t] = f2bf(o * rs * p.gla_ng[h * 128 + t] * silu(gg));
  }
  __syncthreads();
}

DI void p2a_ssd_sample(const Params& p, int item, char* smem) {
  const int grp = item & 1, s = item >> 1, tok = T_P + s;
  const int t = threadIdx.x, lane = t & 63, w = t >> 6;
  const u16* proj = (const u16*)(p.ws + OFF_PROJ) + (size_t)tok * NP;
  float* x_s = (float*)smem;
  float* B_s = x_s + 256;
  float* C_s = B_s + 64;
  float* y_s = C_s + 64;
  float* red_s = y_s + 256;
  for (int i = t; i < 384; i += 256) {
    int ch = i < 256 ? grp * 256 + i : (i < 320 ? 512 + grp * 64 + (i - 256) : 640 + grp * 64 + (i - 320));
    const float* buf = p.st_conv + (size_t)s * 3 * 768;
    float b0 = buf[ch], b1 = buf[768 + ch], b2 = buf[1536 + ch], u = bf2f(proj[CX + ch]);
    float sv = p.conv_b[ch] + b0 * p.conv_w[ch] + b1 * p.conv_w[768 + ch] + b2 * p.conv_w[1536 + ch] + u * p.conv_w[2304 + ch];
    x_s[i] = silu(sv);
    float* co = p.out + O_CONVS + (size_t)s * 3 * 768;
    co[ch] = b1; co[768 + ch] = b2; co[1536 + ch] = u;
  }
  __syncthreads();
  const int pp = t >> 2, nq = t & 3;
  float ssq = 0.f;
#pragma unroll
  for (int hl = 0; hl < 4; ++hl) {
    int hd = grp * 4 + hl;
    float dt = softplus(bf2f(proj[CDT + hd]) + p.dt_bias[hd]);
    float dA = expf(-expf(p.a_log[hd]) * dt);
    float xv = x_s[hl * 64 + pp];
    const float4* h0 = (const float4*)(p.st_ssm + (size_t)((s * 8 + hd) * 64 + pp) * 64 + nq * 16);
    float4* ho = (float4*)(p.out + O_SSMS + (size_t)((s * 8 + hd) * 64 + pp) * 64 + nq * 16);
    float yp = 0.f, dx = dt * xv;
#pragma unroll
    for (int q = 0; q < 4; ++q) {
      float4 hv = h0[q];
      int n = nq * 16 + q * 4;
      hv.x = dA * hv.x + dx * B_s[n]; hv.y = dA * hv.y + dx * B_s[n + 1]; hv.z = dA * hv.z + dx * B_s[n + 2]; hv.w = dA * hv.w + dx * B_s[n + 3];
      ho[q] = hv;
      yp += hv.x * C_s[n] + hv.y * C_s[n + 1] + hv.z * C_s[n + 2] + hv.w * C_s[n + 3];
    }
    yp += __shfl_xor(yp, 1);
    yp += __shfl_xor(yp, 2);
    float z = bf2f(proj[CZ + grp * 256 + hl * 64 + pp]);
    float y = (yp + p.d_skip[hd] * xv) * silu(z);
    if (nq == 0) { y_s[hl * 64 + pp] = y; ssq += y * y; }
  }
  ssq = red64(ssq);
  if (lane == 0) red_s[w] = ssq;
  __syncthreads();
  {
    float rs = rsqrtf((red_s[0] + red_s[1] + red_s[2] + red_s[3]) * (1.f / 256.f) + 1e-6f);
    u16* U = (u16*)(p.ws + OFF_X1) + (size_t)tok * 1024;
    U[512 + grp * 256 + t] = f2bf(y_s[t] * rs * p.ssd_ng[grp * 256 + t]);
  }
  __syncthreads();
}

DI void p2b_item(const Params& p, int item) {
  const int t = threadIdx.x;
  if (item < 512) {
    int gid = item * 256 + t;
    int dp = gid & 31, e = (gid >> 5) & 127, h = (gid >> 12) & 3, b = gid >> 14;
    const u16* dS = (const u16*)(p.ws + OFF_X1);
    u16* Sp = (u16*)(p.ws + OFF_X2);
    const float* gg = (const float*)(p.ws + OFF_GG);
    float S0 = 0.f, S1 = 0.f;
#pragma unroll 4
    for (int c = 0; c < 32; ++c) {
      size_t base = ((size_t)((b * 32 + c) * 4 + h) * 128 + e) * 64 + dp * 2;
      *(unsigned*)(Sp + base) = pack2(S0, S1);
      unsigned ds = *(const unsigned*)(dS + base);
      float2 g = *(const float2*)(gg + ((b * 32 + c) * 4 + h) * 64 + dp * 2);
      S0 = g.x * S0 + bflo(ds);
      S1 = g.y * S1 + bfhi(ds);
    }
    float* o = p.out + O_GLAP + (size_t)((b * 4 + h) * 64 + dp * 2) * 128 + e;
    o[0] = S0; o[128] = S1;
  } else {
    int gid = (item - 512) * 256 + t;
    int np = gid & 31, pp = (gid >> 5) & 63, hd = (gid >> 11) & 7, b = gid >> 14;
    const u16* dh = (const u16*)(p.ws + OFF_X1 + 16777216);
    u16* hp = (u16*)(p.ws + OFF_X2 + 16777216);
    const float* gs = (const float*)(p.ws + OFF_GS);
    float h0 = 0.f, h1 = 0.f;
#pragma unroll 4
    for (int c = 0; c < 32; ++c) {
      size_t base = ((size_t)((b * 32 + c) * 8 + hd) * 64 + pp) * 64 + np * 2;
      *(unsigned*)(hp + base) = pack2(h0, h1);
      unsigned dv = *(const unsigned*)(dh + base);
      float g = gs[(b * 32 + c) * 8 + hd];
      h0 = g * h0 + bflo(dv);
      h1 = g * h1 + bfhi(dv);
    }
    float2 r; r.x = h0; r.y = h1;
    *(float2*)(p.out + O_SSMP + (size_t)((b * 8 + hd) * 64 + pp) * 64 + np * 2) = r;
  }
}

DI void load_img64(const u16* src, size_t ld, char* img) {
  const int t = threadIdx.x, r = t >> 3, ch = t & 7;
#pragma unroll
  for (int i = 0; i < 2; ++i) {
    int row = r + 32 * i;
    *(u32x4*)(img + chunk_off(row, ch)) = *(const u32x4*)(src + (size_t)row * ld + ch * 8);
  }
}

DI void p2c_gla(const Params& p, int item, char* smem) {
  const int h = item & 3, c = (item >> 2) & 31, b = item >> 7;
  const int t = threadIdx.x, lane = t & 63, w = t >> 6, hh = lane >> 5;
  const int tok0 = b * 2048 + c * 64;
  const u16* proj = (const u16*)(p.ws + OFF_PROJ);
  char* Q = smem;
  char* Kt = smem + 8192;
  char* VT = smem + 16384;
  char* Aimg = smem + 32768;
  float* part_s = (float*)(smem + 40960);
  load_img64(proj + (size_t)tok0 * NP + CQ + h * 64, NP, Q);
  load_img64(proj + (size_t)tok0 * NP + CK + h * 64, NP, Kt);
  build_vt(proj, tok0, CV + h * 128, VT);
  const u16* Sp = (const u16*)(p.ws + OFF_X2) + (size_t)((b * 32 + c) * 4 + h) * 8192;
  bf16x8 sfrag[4];
#pragma unroll
  for (int ks = 0; ks < 4; ++ks) sfrag[ks] = *(const bf16x8*)(Sp + (w * 32 + (lane & 31)) * 64 + (ks * 2 + hh) * 8);
  __syncthreads();
  {
    const int it = w >> 1, jt = w & 1;
    f32x16 a = zero16();
    mma64(a, Q, it * 32, Kt, jt * 32, lane);
#pragma unroll
    for (int r = 0; r < 16; ++r) {
      int i = it * 32 + crow(r, hh), j = jt * 32 + (lane & 31);
      *(u16*)(Aimg + img_off(i, j)) = f2bf(i >= j ? a[r] : 0.f);
    }
  }
  __syncthreads();
  f32x16 acc[2];
#pragma unroll
  for (int it = 0; it < 2; ++it) {
    acc[it] = zero16();
#pragma unroll
    for (int ks = 0; ks < 4; ++ks) {
      acc[it] = MFMA(frag(Aimg, it * 32, ks, lane), frag(VT, w * 32, ks, lane), acc[it]);
      acc[it] = MFMA(frag(Q, it * 32, ks, lane), sfrag[ks], acc[it]);
    }
#pragma unroll
    for (int r = 0; r < 16; ++r) {
      float ss = red32(acc[it][r] * acc[it][r]);
      if ((lane & 31) == 0) part_s[w * 64 + it * 32 + crow(r, hh)] = ss;
    }
  }
  __syncthreads();
  u16* U = (u16*)(p.ws + OFF_X1);
  const int e = w * 32 + (lane & 31);
  const float gn = p.gla_ng[h * 128 + e];
#pragma unroll
  for (int it = 0; it < 2; ++it)
#pragma unroll
    for (int r = 0; r < 16; ++r) {
      int i = it * 32 + crow(r, hh);
      float rs = rsqrtf((part_s[i] + part_s[64 + i] + part_s[128 + i] + part_s[192 + i]) * (1.f / 128.f) + 1e-6f);
      float gg = bf2f(proj[(size_t)(tok0 + i) * NP + CG + h * 128 + e]);
      U[(size_t)(tok0 + i) * 1024 + h * 128 + e] = f2bf(acc[it][r] * rs * gn * silu(gg));
    }
  __syncthreads();
}

DI void p2c_ssd(const Params& p, int item, char* smem) {
  const int grp = item & 1, c = (item >> 1) & 31, b = item >> 6;
  const int t = threadIdx.x, lane = t & 63, w = t >> 6, hh = lane >> 5;
  const int tok0 = b * 2048 + c * 64;
  const u16* proj = (const u16*)(p.ws + OFF_PROJ);
  const u16* xbcc = (const u16*)((const char*)p.out + OUTB_XBCC);
  char* Cimg = smem;
  char* Bimg = smem + 8192;
  char* Ximg = smem + 16384;
  char* Simg = smem + 24576;
  float* cum_s = (float*)(smem + 32768);
  float* dt_s = cum_s + 256;
  float* part_s = dt_s + 256;
  load_img64(xbcc + (size_t)tok0 * 768 + 640 + grp * 64, 768, Cimg);
  load_img64(xbcc + (size_t)tok0 * 768 + 512 + grp * 64, 768, Bimg);
  cum_s[t] = ((const float*)(p.ws + OFF_CUM))[(size_t)(tok0 + (t & 63)) * 8 + grp * 4 + (t >> 6)];
  dt_s[t] = ((const float*)(p.ws + OFF_DT))[(size_t)(tok0 + (t & 63)) * 8 + grp * 4 + (t >> 6)];
  __syncthreads();
  const int it = w >> 1, pt = w & 1;
  f32x16 cb = zero16();
  mma64(cb, Cimg, it * 32, Bimg, pt * 32, lane);
  u16* U = (u16*)(p.ws + OFF_X1);
  f32x16 ssq = zero16();
#pragma unroll 1
  for (int hl = 0; hl < 4; ++hl) {
    const int hd = grp * 4 + hl;
    {
      int pp = t & 63, jg = t >> 6;
#pragma unroll
      for (int cc = 0; cc < 2; ++cc) {
        int ch = jg * 2 + cc;
        unsigned pk[4];
#pragma unroll
        for (int q = 0; q < 4; ++q) {
          int j0 = ch * 8 + 2 * q;
          float a0 = bf2f(xbcc[(size_t)(tok0 + j0) * 768 + grp * 256 + hl * 64 + pp]) * dt_s[hl * 64 + j0];
          float a1 = bf2f(xbcc[(size_t)(tok0 + j0 + 1) * 768 + grp * 256 + hl * 64 + pp]) * dt_s[hl * 64 + j0 + 1];
          pk[q] = pack2(a0, a1);
        }
        u32x4 v; v[0] = pk[0]; v[1] = pk[1]; v[2] = pk[2]; v[3] = pk[3];
        *(u32x4*)(Ximg + chunk_off(pp, ch)) = v;
      }
    }
#pragma unroll
    for (int r = 0; r < 16; ++r) {
      int i = it * 32 + crow(r, hh), j = pt * 32 + (lane & 31);
      float sv = i >= j ? cb[r] * expf(cum_s[hl * 64 + i] - cum_s[hl * 64 + j]) : 0.f;
      *(u16*)(Simg + img_off(i, j)) = f2bf(sv);
    }
    const u16* hp = (const u16*)(p.ws + OFF_X2 + 16777216) + (size_t)((b * 32 + c) * 8 + hd) * 4096;
    bf16x8 hf[4];
#pragma unroll
    for (int ks = 0; ks < 4; ++ks) hf[ks] = *(const bf16x8*)(hp + (pt * 32 + (lane & 31)) * 64 + (ks * 2 + hh) * 8);
    __syncthreads();
    f32x16 y = zero16();
#pragma unroll
    for (int ks = 0; ks < 4; ++ks) y = MFMA(frag(Cimg, it * 32, ks, lane), hf[ks], y);
#pragma unroll
    for (int r = 0; r < 16; ++r) y[r] *= expf(cum_s[hl * 64 + it * 32 + crow(r, hh)]);
    mma64(y, Simg, it * 32, Ximg, pt * 32, lane);
    const int ch = grp * 256 + hl * 64 + pt * 32 + (lane & 31);
    const float dsk = p.d_skip[hd];
#pragma unroll
    for (int r = 0; r < 16; ++r) {
      int i = it * 32 + crow(r, hh);
      float xs = bf2f(xbcc[(size_t)(tok0 + i) * 768 + ch]);
      float z = bf2f(proj[(size_t)(tok0 + i) * NP + CZ + ch]);
      float yo = (y[r] + dsk * xs) * silu(z);
      u16 yb = f2bf(yo);
      U[(size_t)(tok0 + i) * 1024 + 512 + ch] = yb;
      yo = bf2f(yb);
      ssq[r] += yo * yo;
    }
    __syncthreads();
  }
#pragma unroll
  for (int r = 0; r < 16; ++r) {
    float ss = red32(ssq[r]);
    if ((lane & 31) == 0) part_s[pt * 64 + it * 32 + crow(r, hh)] = ss;
  }
  __syncthreads();
#pragma unroll 1
  for (int hl = 0; hl < 4; ++hl) {
    const int ch = grp * 256 + hl * 64 + pt * 32 + (lane & 31);
    const float gn = p.ssd_ng[ch];
#pragma unroll
    for (int r = 0; r < 16; ++r) {
      int i = it * 32 + crow(r, hh);
      float rs = rsqrtf((part_s[i] + part_s[64 + i]) * (1.f / 256.f) + 1e-6f);
      size_t a = (size_t)(tok0 + i) * 1024 + 512 + ch;
      U[a] = f2bf(bf2f(U[a]) * rs * gn);
    }
  }
  __syncthreads();
}

constexpr int N_PHASES = 8;
__host__ __device__ constexpr int phase_items(int ph) {
  return ph == 0 ? 4128 + 1760 : ph == 1 ? 5031 : ph == 2 ? 1024 + 512 + 512 + 256 : ph == 3 ? 1024 : ph == 4 ? 1024 + 512 : ph == 5 ? 1032
         : ph == 6 ? 1032 : 4128;
}

#if MK_MULTI
#define GRID_SYNC(PH)
#else
#define GRID_SYNC(PH) if (PH < p.ph_hi) cg::this_grid().sync();
#endif
#define PHASE(PH, BODY)                                                                    \
  if (p.ph_lo <= PH && PH <= p.ph_hi) {                                                    \
    for (int item = blockIdx.x; item < phase_items(PH); item += gridDim.x) { BODY; }       \
    GRID_SYNC(PH)                                                                          \
  }

__global__ void __launch_bounds__(256, 2) mega(Params p) {
  __shared__ __attribute__((aligned(16))) char smem[65536 + 1024];
  PHASE(0, p0_item(p, item, smem))
  PHASE(1, p1_tile(p, item, smem))
  PHASE(2, if (item < 1024) p2a_gla(p, item, smem); else if (item < 1536) p2a_ssd(p, item - 1024, smem);
           else if (item < 2048) p2a_gla_sample(p, item - 1536, smem); else p2a_ssd_sample(p, item - 2048, smem))
  PHASE(3, p2b_item(p, item))
  PHASE(4, if (item < 1024) p2c_gla(p, item, smem); else p2c_ssd(p, item - 1024, smem))
  PHASE(5, p3_tile(p, item, smem))
  PHASE(6, p4_tile(p, item, smem))
  PHASE(7, p5_item(p, item))
}

extern "C" void kernel_launch(void* const* d_in, const int* in_sizes, int n_in, void* d_out, int out_size, void* d_ws, size_t ws_size,
                              hipStream_t stream) {
  (void)in_sizes; (void)n_in; (void)out_size;
  if (ws_size < WS_NEED) fprintf(stderr, "kernel_launch: workspace too small (%zu < %zu)\n", ws_size, WS_NEED);
  Params p{};
  const float** f = (const float**)&p;
  for (int i = 0; i < 20; ++i) f[i] = (const float*)d_in[i];
  p.out = (float*)d_out;
  p.ws = (char*)d_ws;
#if MK_MULTI
  for (int ph = 0; ph < N_PHASES; ++ph) {
    p.ph_lo = ph; p.ph_hi = ph;
    hipLaunchKernelGGL(mega, dim3(phase_items(ph)), dim3(256), 0, stream, p);
  }
#else
  static int grid_blocks = 0;
  if (!grid_blocks) {
    int dev = 0, cus = 0, per_cu = 0;
    hipGetDevice(&dev);
    hipDeviceGetAttribute(&cus, hipDeviceAttributeMultiprocessorCount, dev);
    hipOccupancyMaxActiveBlocksPerMultiprocessor(&per_cu, mega, 256, 0);
    if (per_cu < 1) per_cu = 1;
    if (per_cu > 2) per_cu = 2;
    grid_blocks = cus * per_cu;
  }
  p.ph_lo = 0; p.ph_hi = N_PHASES - 1;
  void* args[] = {&p};
  hipError_t e = hipLaunchCooperativeKernel((void*)mega, dim3(grid_blocks), dim3(256), args, 0, stream);
  if (e != hipSuccess) fprintf(stderr, "cooperative launch failed: %s (grid %d)\n", hipGetErrorString(e), grid_blocks);
#endif
}
```

```cpp
#include <hip/hip_runtime.h>
#include <hip/hip_cooperative_groups.h>
#include <cstdio>
namespace cg = cooperative_groups;

#ifndef MK_MULTI
#define MK_MULTI 0
#endif

typedef unsigned short u16;
typedef __attribute__((ext_vector_type(8))) short bf16x8;
typedef __attribute__((ext_vector_type(16))) float f32x16;
typedef __attribute__((ext_vector_type(4))) unsigned u32x4;
#define DI __device__ __forceinline__
#define MFMA(a, b, c) __builtin_amdgcn_mfma_f32_32x32x16_bf16((a), (b), (c), 0, 0, 0)

constexpr int T_ALL = 16512, T_P = 16384, NP = 4992;
constexpr int CQ = 0, CK = 256, CV = 512, CG = 1024, CZ = 1536, CX = 2048, CGA = 2816, CGB = 3840, CAL = 4864, CDT = 4880;
constexpr size_t OFF_PROJ = 0;
constexpr size_t OFF_WIN = 164855808;
constexpr size_t OFF_WG = 175079424;
constexpr size_t OFF_WS = 176128000;
constexpr size_t OFF_WO = 177176576;
constexpr size_t OFF_X1 = 179273728;
constexpr size_t OFF_X2 = 213090304;
constexpr size_t OFF_DT = 246906880;
constexpr size_t OFF_CUM = 247431168;
constexpr size_t OFF_GG = 247955456;
constexpr size_t OFF_GS = 248217600;
constexpr size_t OFF_BAR = 248225792;
constexpr size_t OFF_CNT = OFF_BAR + 13824;
constexpr size_t OFF_RPART = OFF_CNT + 1024;
constexpr size_t WS_NEED = OFF_RPART + 524288;
constexpr size_t O_YS = 16777216, O_GLAP = 16908288, O_SSMP = 17170432, O_CONVP = 17432576, O_GLAS = 17451008, O_SSMS = 21645312, O_CONVS = 25839616;
constexpr size_t OUTB_HN = 0, OUTB_XBCC = 33816576;
constexpr size_t OUTB_QK = 0, OUTB_VT = 16777216;

struct Params {
  const float *x_p, *x_s, *st_gla, *st_ssm, *st_conv, *norm_g, *w_in, *w_a2, *b_a2, *gla_ng, *conv_w, *conv_b, *dt_bias, *a_log,
      *d_skip, *ssd_ng, *w_brg, *w_brs, *w_out, *fin_g;
  float* out;
  char* ws;
  int ph_lo, ph_hi;
};

DI u16 f2bf(float x) { unsigned u = __float_as_uint(x); u += 0x7fffu + ((u >> 16) & 1u); return (u16)(u >> 16); }
DI float bf2f(u16 v) { return __uint_as_float(((unsigned)v) << 16); }
DI unsigned pack2(float a, float b) { return (unsigned)f2bf(a) | ((unsigned)f2bf(b) << 16); }
DI float bflo(unsigned u) { return __uint_as_float(u << 16); }
DI float bfhi(unsigned u) { return __uint_as_float(u & 0xffff0000u); }
DI int crow(int r, int h) { return (r & 3) + 8 * (r >> 2) + 4 * h; }
DI int img_off(int row, int k) { return row * 128 + ((((k >> 3) ^ (row >> 1)) & 7) << 4) + ((k & 7) << 1); }
DI int chunk_off(int row, int chunk) { return row * 128 + (((chunk ^ (row >> 1)) & 7) << 4); }
DI bf16x8 frag(const char* img, int row0, int ks, int lane) {
  int row = row0 + (lane & 31);
  return *(const bf16x8*)(img + chunk_off(row, ks * 2 + (lane >> 5)));
}
DI void mma64(f32x16& acc, const char* ia, int ra, const char* ib, int rb, int lane) {
#pragma unroll
  for (int ks = 0; ks < 4; ++ks) acc = MFMA(frag(ia, ra, ks, lane), frag(ib, rb, ks, lane), acc);
}
DI float sigm(float x) { return __builtin_amdgcn_rcpf(1.f + __expf(-x)); }
DI float silu(float x) { return x * __builtin_amdgcn_rcpf(1.f + __expf(-x)); }
DI float softplus(float x) { return fmaxf(x, 0.f) + __logf(1.f + __expf(-fabsf(x))); }
DI float logsig(float x) { return fminf(x, 0.f) - __logf(1.f + __expf(-fabsf(x))); }
DI float red32(float v) {
#pragma unroll
  for (int o = 16; o > 0; o >>= 1) v += __shfl_xor(v, o);
  return v;
}
DI float red64(float v) {
#pragma unroll
  for (int o = 32; o > 0; o >>= 1) v += __shfl_xor(v, o);
  return v;
}
DI f32x16 zero16() { f32x16 z; for (int i = 0; i < 16; ++i) z[i] = 0.f; return z; }

DI void transpose_tile(const float* __restrict__ src, int src_ld, int K, u16* __restrict__ dst, int n0, int k0, int mapcols, char* smem) {
  float* tile = (float*)smem;
  const int t = threadIdx.x, lane = t & 63, w = t >> 6;
  int n = n0 + lane, col;
  if (mapcols) {
    if (n < 1536) col = n; else if (n < 2816) col = n + 16; else if (n < 4864) col = n + 24;
    else if (n < 4880) col = 1536 + (n - 4864); else if (n < 4888) col = 2832 + (n - 4880); else col = -1;
  } else col = n;
#pragma unroll
  for (int r = 0; r < 16; ++r) {
    int kk = r * 4 + w;
    tile[kk * 65 + lane] = col >= 0 ? src[(size_t)(k0 + kk) * src_ld + col] : 0.f;
  }
  __syncthreads();
  {
    int nn = t >> 2, kq = t & 3;
    unsigned pk[8];
#pragma unroll
    for (int i = 0; i < 8; ++i) pk[i] = pack2(tile[(kq * 16 + 2 * i) * 65 + nn], tile[(kq * 16 + 2 * i + 1) * 65 + nn]);
    u32x4* d = (u32x4*)(dst + (size_t)(n0 + nn) * K + k0 + kq * 16);
    u32x4 a, b;
    a[0] = pk[0]; a[1] = pk[1]; a[2] = pk[2]; a[3] = pk[3]; b[0] = pk[4]; b[1] = pk[5]; b[2] = pk[6]; b[3] = pk[7];
    d[0] = a; d[1] = b;
  }
  __syncthreads();
}

DI void p0_item(const Params& p, int item, char* smem) {
  const int t = threadIdx.x, lane = t & 63, w = t >> 6;
  if (item < 2064) {
    const int row0 = item * 8 + w * 2;
    float4 v[2][4];
    float ss[2] = {0.f, 0.f};
#pragma unroll
    for (int rr = 0; rr < 2; ++rr) {
      const int row = row0 + rr;
      const float* xr = row < T_P ? p.x_p + (size_t)row * 1024 : p.x_s + (size_t)(row - T_P) * 1024;
#pragma unroll
      for (int i = 0; i < 4; ++i) v[rr][i] = ((const float4*)xr)[lane + 64 * i];
    }
#pragma unroll
    for (int rr = 0; rr < 2; ++rr) {
#pragma unroll
      for (int i = 0; i < 4; ++i) ss[rr] += v[rr][i].x * v[rr][i].x + v[rr][i].y * v[rr][i].y + v[rr][i].z * v[rr][i].z + v[rr][i].w * v[rr][i].w;
      ss[rr] = red64(ss[rr]);
    }
#pragma unroll
    for (int rr = 0; rr < 2; ++rr) {
      const float rs = rsqrtf(ss[rr] * (1.f / 1024.f) + 1e-6f);
      u16* hn = (u16*)((char*)p.out + OUTB_HN) + (size_t)(row0 + rr) * 1024;
#pragma unroll
      for (int i = 0; i < 4; ++i) {
        float4 g = ((const float4*)p.norm_g)[lane + 64 * i];
        uint2 o;
        o.x = pack2(v[rr][i].x * rs * g.x, v[rr][i].y * rs * g.y);
        o.y = pack2(v[rr][i].z * rs * g.z, v[rr][i].w * rs * g.w);
        *(uint2*)(hn + (lane + 64 * i) * 4) = o;
      }
    }
  } else {
    int idx = item - 2064;
    if (idx < 1248) transpose_tile(p.w_in, 4888, 1024, (u16*)(p.ws + OFF_WIN), (idx >> 4) * 64, (idx & 15) * 64, 1, smem);
    else if (idx < 1376) { idx -= 1248; transpose_tile(p.w_brg, 1024, 1024, (u16*)(p.ws + OFF_WG), (idx >> 3) * 64, (idx & 7) * 64, 0, smem); }
    else if (idx < 1504) { idx -= 1376; transpose_tile(p.w_brs, 1024, 1024, (u16*)(p.ws + OFF_WG) + 512, (idx >> 3) * 64, (idx & 7) * 64, 0, smem); }
    else { idx -= 1504; transpose_tile(p.w_out, 1024, 1024, (u16*)(p.ws + OFF_WO), (idx >> 4) * 64, (idx & 15) * 64, 0, smem); }
  }
}

#define GLDS(gp, lp) __builtin_amdgcn_global_load_lds((const unsigned*)(gp), (__attribute__((address_space(3))) unsigned*)(lp), 16, 0, 0)
DI void gemm_range(const u16* __restrict__ A, int lda, const u16* __restrict__ B, int ldb, int kt0, int kt1, int nk, bool prologue, char* smem, f32x16 (&acc)[2][2]) {
  const int t = threadIdx.x, lane = t & 63, w = t >> 6, wm = w >> 1, wn = w & 1;
  const int lr = t >> 3, lc = (t ^ (t >> 4)) & 7;
  const u16* ap = A + (size_t)lr * lda + lc * 8;
  const u16* bp = B + (size_t)lr * ldb + lc * 8;
  char* sdst = smem + t * 16;
  const int l = lane & 31, hh = lane >> 5, sw = (l >> 1) & 7;
  const unsigned lbase = (unsigned)(size_t)smem;
  const unsigned rA = lbase + (wm * 64 + l) * 128, rB = lbase + 16384 + (wn * 64 + l) * 128;
  const unsigned x0 = (((0 + hh) ^ sw) & 7) << 4, x1 = (((2 + hh) ^ sw) & 7) << 4, x2 = (((4 + hh) ^ sw) & 7) << 4, x3 = (((6 + hh) ^ sw) & 7) << 4;
  if (prologue) {
#pragma unroll
    for (int i = 0; i < 4; ++i) { GLDS(ap + (size_t)(32 * i) * lda, sdst + i * 4096); GLDS(bp + (size_t)(32 * i) * ldb, sdst + 16384 + i * 4096); }
    asm volatile("s_waitcnt vmcnt(0)" ::: "memory");
    __builtin_amdgcn_s_barrier();
    asm volatile("" ::: "memory");
  }
#pragma unroll 1
  for (int kt = kt0; kt < kt1; ++kt) {
    if (kt + 1 < nk) {
      char* d = sdst + ((kt + 1) & 1) * 32768;
      const u16* a2 = ap + (kt + 1) * 64;
      const u16* b2 = bp + (kt + 1) * 64;
#pragma unroll
      for (int i = 0; i < 4; ++i) { GLDS(a2 + (size_t)(32 * i) * lda, d + i * 4096); GLDS(b2 + (size_t)(32 * i) * ldb, d + 16384 + i * 4096); }
    }
    const unsigned so = (kt & 1) * 32768;
#define RD4(a0_, a1_, b0_, b1_, x_) asm volatile("ds_read_b128 %0, %4\n\tds_read_b128 %1, %4 offset:4096\n\tds_read_b128 %2, %5\n\tds_read_b128 %3, %5 offset:4096" \
        : "=&v"(a0_), "=&v"(a1_), "=&v"(b0_), "=&v"(b1_) : "v"(rA + so + (x_)), "v"(rB + so + (x_)) : "memory")
#define WT4(n_, a0_, a1_, b0_, b1_) asm volatile("s_waitcnt lgkmcnt(" #n_ ")" : "+v"(a0_), "+v"(a1_), "+v"(b0_), "+v"(b1_))
#define MM4(a0_, a1_, b0_, b1_) do { acc[0][0] = MFMA(a0_, b0_, acc[0][0]); acc[0][1] = MFMA(a0_, b1_, acc[0][1]); \
        acc[1][0] = MFMA(a1_, b0_, acc[1][0]); acc[1][1] = MFMA(a1_, b1_, acc[1][1]); } while (0)
    bf16x8 a00, a01, b00, b01, a10, a11, b10, b11, a20, a21, b20, b21, a30, a31, b30, b31;
    RD4(a00, a01, b00, b01, x0);
    RD4(a10, a11, b10, b11, x1);
    WT4(4, a00, a01, b00, b01);
    MM4(a00, a01, b00, b01);
    RD4(a20, a21, b20, b21, x2);
    WT4(4, a10, a11, b10, b11);
    MM4(a10, a11, b10, b11);
    RD4(a30, a31, b30, b31, x3);
    WT4(4, a20, a21, b20, b21);
    MM4(a20, a21, b20, b21);
    WT4(0, a30, a31, b30, b31);
    MM4(a30, a31, b30, b31);
#undef RD4
#undef WT4
#undef MM4
    asm volatile("s_waitcnt vmcnt(0)" ::: "memory");
    __builtin_amdgcn_s_barrier();
    asm volatile("" ::: "memory");
  }
}

DI void gemm_core(const u16* __restrict__ A, int lda, const u16* __restrict__ B, int ldb, int nk, char* smem, f32x16 (&acc)[2][2]) {
  gemm_range(A, lda, B, ldb, 0, nk, nk, true, smem, acc);
}

DI void acc_to_lds(const f32x16 (&acc)[2][2], float* T) {
  const int lane = threadIdx.x & 63, w = threadIdx.x >> 6, wm = w >> 1, wn = w & 1, h = lane >> 5;
  float* base = T + (wm * 64 + 4 * h) * 128 + wn * 64 + (lane & 31);
#pragma unroll
  for (int i = 0; i < 2; ++i)
#pragma unroll
    for (int j = 0; j < 2; ++j)
#pragma unroll
      for (int r2 = 0; r2 < 16; ++r2) base[(i * 32 + (r2 & 3) + 8 * (r2 >> 2)) * 128 + j * 32] = acc[i][j][r2];
}
#define EPI_ROW(it2) (w * 32 + (it2) * 4 + (lane >> 4))
#define EPI_COL ((lane & 15) * 8)

DI void p1_tile(const Params& p, int tile, char* smem) {
  int mblk, nblk;
  if (tile < 4992) {
    const int b = tile & 511, k = tile >> 9, xcd = b & 7, q = k * 64 + (b >> 3);
    const int half = q >= 312 ? 1 : 0, r = q - half * 312;
    int nstep, rr;
    if (r < 256) { nstep = r >> 6; rr = r & 63; } else { nstep = 4; rr = r - 256; }
    mblk = xcd * 16 + half * 8 + (rr & 7);
    nblk = nstep * 8 + (rr >> 3);
  } else { mblk = 128; nblk = tile - 4992; }
  const int m0 = mblk * 128, n0 = nblk * 128;
  const u16* hn = (const u16*)((const char*)p.out + OUTB_HN);
  f32x16 acc[2][2];
  for (int i = 0; i < 2; ++i) for (int j = 0; j < 2; ++j) acc[i][j] = zero16();
  gemm_core(hn + (size_t)m0 * 1024, 1024, (const u16*)(p.ws + OFF_WIN) + (size_t)n0 * 1024, 1024, 16, smem, acc);
  const int lane = threadIdx.x & 63, w = threadIdx.x >> 6;
  float* T = (float*)smem;
  acc_to_lds(acc, T);
  __syncthreads();
  u16* proj = (u16*)(p.ws + OFF_PROJ) + (size_t)m0 * NP + n0 + EPI_COL;
#pragma unroll
  for (int it2 = 0; it2 < 8; ++it2) {
    int row = EPI_ROW(it2);
    float4 v0 = *(const float4*)(T + row * 128 + EPI_COL), v1 = *(const float4*)(T + row * 128 + EPI_COL + 4);
    u32x4 o; o[0] = pack2(v0.x, v0.y); o[1] = pack2(v0.z, v0.w); o[2] = pack2(v1.x, v1.y); o[3] = pack2(v1.z, v1.w);
    *(u32x4*)(proj + (size_t)row * NP) = o;
  }
  __syncthreads();
}

DI void p3_tile(const Params& p, int tile, char* smem) {
  const int tb = tile & 511, tk = tile >> 9, tj = tb >> 3;
  int m0 = (tk * 64 + (tb & 7) * 8 + (tj >> 3)) * 128, n0 = (tj & 7) * 128;
  const u16* U = (const u16*)(p.ws + OFF_X1) + (size_t)m0 * 1024;
  const u16* Wm = (const u16*)(p.ws + OFF_WG) + (size_t)n0 * 1024;
  const int lane = threadIdx.x & 63, w = threadIdx.x >> 6;
  const u16* gate = (const u16*)(p.ws + OFF_PROJ) + (size_t)m0 * NP + n0 + EPI_COL;
  u16* mg = (u16*)(p.ws + OFF_X2) + (size_t)m0 * 1024 + n0 + EPI_COL;
  float* T = (float*)smem;
  f32x16 acc[2][2], acc2[2][2];
  for (int i = 0; i < 2; ++i) for (int j = 0; j < 2; ++j) { acc[i][j] = zero16(); acc2[i][j] = zero16(); }
  gemm_range(U, 1024, Wm, 1024, 0, 8, 16, true, smem, acc);
  gemm_range(U, 1024, Wm, 1024, 8, 16, 16, false, smem, acc2);
  acc_to_lds(acc, T);
  __syncthreads();
  u32x4 gbv[8];
#pragma unroll
  for (int it2 = 0; it2 < 8; ++it2) gbv[it2] = *(const u32x4*)(gate + (size_t)EPI_ROW(it2) * NP + CGB);
  u32x4 m1[8];
#pragma unroll
  for (int it2 = 0; it2 < 8; ++it2) {
    int row = EPI_ROW(it2);
    u32x4 ga = *(const u32x4*)(gate + (size_t)row * NP + CGA);
    float4 v0 = *(const float4*)(T + row * 128 + EPI_COL), v1 = *(const float4*)(T + row * 128 + EPI_COL + 4);
    m1[it2][0] = pack2(v0.x * sigm(bflo(ga[0])), v0.y * sigm(bfhi(ga[0])));
    m1[it2][1] = pack2(v0.z * sigm(bflo(ga[1])), v0.w * sigm(bfhi(ga[1])));
    m1[it2][2] = pack2(v1.x * sigm(bflo(ga[2])), v1.y * sigm(bfhi(ga[2])));
    m1[it2][3] = pack2(v1.z * sigm(bflo(ga[3])), v1.w * sigm(bfhi(ga[3])));
  }
  __syncthreads();
  acc_to_lds(acc2, T);
  __syncthreads();
#pragma unroll
  for (int it2 = 0; it2 < 8; ++it2) {
    int row = EPI_ROW(it2);
    const u32x4 gb = gbv[it2];
    float4 v0 = *(const float4*)(T + row * 128 + EPI_COL), v1 = *(const float4*)(T + row * 128 + EPI_COL + 4);
    u32x4 o;
    o[0] = pack2(bflo(m1[it2][0]) + v0.x * sigm(bflo(gb[0])), bfhi(m1[it2][0]) + v0.y * sigm(bfhi(gb[0])));
    o[1] = pack2(bflo(m1[it2][1]) + v0.z * sigm(bflo(gb[1])), bfhi(m1[it2][1]) + v0.w * sigm(bfhi(gb[1])));
    o[2] = pack2(bflo(m1[it2][2]) + v1.x * sigm(bflo(gb[2])), bfhi(m1[it2][2]) + v1.y * sigm(bfhi(gb[2])));
    o[3] = pack2(bflo(m1[it2][3]) + v1.z * sigm(bflo(gb[3])), bfhi(m1[it2][3]) + v1.w * sigm(bfhi(gb[3])));
    *(u32x4*)(mg + (size_t)row * 1024) = o;
  }
  __syncthreads();
}

DI void p4_tile(const Params& p, int tile, char* smem) {
  const int tb = tile & 511, tk = tile >> 9, tj = tb >> 3;
  const int mb = tk * 64 + (tb & 7) * 8 + (tj >> 3), nb = tj & 7, m0 = mb * 128, n0 = nb * 128;
  const u16* mg = (const u16*)(p.ws + OFF_X2);
  const int lane = threadIdx.x & 63, w = threadIdx.x >> 6;
  float* T = (float*)smem;
  f32x16 acc[2][2];
  for (int i = 0; i < 2; ++i) for (int j = 0; j < 2; ++j) acc[i][j] = zero16();
  float4 xa[8], xb[8];
#pragma unroll
  for (int it2 = 0; it2 < 8; ++it2) {
    const float* xr = p.x_p + (size_t)(m0 + EPI_ROW(it2)) * 1024 + n0 + EPI_COL;
    xa[it2] = *(const float4*)xr; xb[it2] = *(const float4*)(xr + 4);
  }
  gemm_core(mg + (size_t)m0 * 1024, 1024, (const u16*)(p.ws + OFF_WO) + (size_t)n0 * 1024, 1024, 16, smem, acc);
  acc_to_lds(acc, T);
  __syncthreads();
  float* rpart = (float*)(p.ws + OFF_RPART);
  unsigned* cnt = (unsigned*)(p.ws + OFF_CNT);
#pragma unroll
  for (int it2 = 0; it2 < 8; ++it2) {
    const int lrow = EPI_ROW(it2);
    float* tp = T + lrow * 128 + EPI_COL;
    float4 v0 = *(const float4*)tp, v1 = *(const float4*)(tp + 4);
    const float4 x0 = xa[it2], x1 = xb[it2];
    v0.x += x0.x; v0.y += x0.y; v0.z += x0.z; v0.w += x0.w; v1.x += x1.x; v1.y += x1.y; v1.z += x1.z; v1.w += x1.w;
    *(float4*)tp = v0; *(float4*)(tp + 4) = v1;
    float ss = v0.x * v0.x + v0.y * v0.y + v0.z * v0.z + v0.w * v0.w + v1.x * v1.x + v1.y * v1.y + v1.z * v1.z + v1.w * v1.w;
    ss += __shfl_xor(ss, 1); ss += __shfl_xor(ss, 2); ss += __shfl_xor(ss, 4); ss += __shfl_xor(ss, 8);
    if ((lane & 15) == 0) __hip_atomic_store(rpart + (size_t)(mb * 8 + nb) * 128 + lrow, ss, __ATOMIC_RELAXED, __HIP_MEMORY_SCOPE_AGENT);
  }
  asm volatile("s_waitcnt vmcnt(0)" ::: "memory");
  __syncthreads();
  if (threadIdx.x == 0) {
    __hip_atomic_fetch_add(cnt + mb, 1u, __ATOMIC_RELAXED, __HIP_MEMORY_SCOPE_AGENT);
    unsigned sp = 0;
    while (__hip_atomic_load(cnt + mb, __ATOMIC_RELAXED, __HIP_MEMORY_SCOPE_AGENT) < 8u) { __builtin_amdgcn_s_sleep(2); if (++sp > (1u << 22)) break; }
  }
  __syncthreads();
  const float4 g0 = *(const float4*)(p.fin_g + n0 + EPI_COL), g1 = *(const float4*)(p.fin_g + n0 + EPI_COL + 4);
#pragma unroll
  for (int it2 = 0; it2 < 8; ++it2) {
    const int lrow = EPI_ROW(it2);
    float tot = 0.f;
#pragma unroll
    for (int q = 0; q < 8; ++q) tot += __hip_atomic_load(rpart + (size_t)(mb * 8 + q) * 128 + lrow, __ATOMIC_RELAXED, __HIP_MEMORY_SCOPE_AGENT);
    const float rs = rsqrtf(tot * (1.f / 1024.f) + 1e-6f);
    const float* tp = T + lrow * 128 + EPI_COL;
    float4 v0 = *(const float4*)tp, v1 = *(const float4*)(tp + 4);
    v0.x *= rs * g0.x; v0.y *= rs * g0.y; v0.z *= rs * g0.z; v0.w *= rs * g0.w; v1.x *= rs * g1.x; v1.y *= rs * g1.y; v1.z *= rs * g1.z; v1.w *= rs * g1.w;
    float* op = p.out + (size_t)(m0 + lrow) * 1024 + n0 + EPI_COL;
    *(float4*)op = v0; *(float4*)(op + 4) = v1;
  }
  __syncthreads();
}

DI f32x16 wgemm32(const u16* __restrict__ A, int lda, const u16* __restrict__ B, int ldb, int k0, int k1, int lane) {
  const u16* ap = A + (size_t)(lane & 31) * lda + (lane >> 5) * 8;
  const u16* bp = B + (size_t)(lane & 31) * ldb + (lane >> 5) * 8;
  f32x16 acc = zero16();
#pragma unroll 8
  for (int k = k0; k < k1; k += 16) acc = MFMA(*(const bf16x8*)(ap + k), *(const bf16x8*)(bp + k), acc);
  return acc;
}
DI void red_put(const f32x16& acc, float* red, int w, int lane) {
#pragma unroll
  for (int r = 0; r < 16; ++r) red[(w * 16 + r) * 64 + lane] = acc[r];
}
DI float red_get(const float* red, int r, int lane) { return red[r * 64 + lane] + red[(16 + r) * 64 + lane] + red[(32 + r) * 64 + lane] + red[(48 + r) * 64 + lane]; }

DI void p3_sample(const Params& p, int item, char* smem) {
  const int mt = item >> 5, nt = item & 31, lane = threadIdx.x & 63, w = threadIdx.x >> 6, hh = lane >> 5;
  const u16* U = (const u16*)(p.ws + OFF_X1) + (size_t)(T_P + mt * 32) * 1024;
  float* red = (float*)smem;
  f32x16 a1 = wgemm32(U, 1024, (const u16*)(p.ws + OFF_WG) + (size_t)nt * 32 * 1024, 1024, w * 128, w * 128 + 128, lane);
  f32x16 a2 = wgemm32(U + 512, 1024, (const u16*)(p.ws + OFF_WG) + (size_t)nt * 32 * 1024 + 512, 1024, w * 128, w * 128 + 128, lane);
  red_put(a1, red, w, lane);
  red_put(a2, red + 4096, w, lane);
  __syncthreads();
  const u16* proj = (const u16*)(p.ws + OFF_PROJ);
  u16* mg = (u16*)(p.ws + OFF_X2);
#pragma unroll
  for (int q = 0; q < 4; ++q) {
    const int r = w * 4 + q, row = T_P + mt * 32 + crow(r, hh), col = nt * 32 + (lane & 31);
    float ga = bf2f(proj[(size_t)row * NP + CGA + col]), gb = bf2f(proj[(size_t)row * NP + CGB + col]);
    mg[(size_t)row * 1024 + col] = f2bf(red_get(red, r, lane) * sigm(ga) + red_get(red + 4096, r, lane) * sigm(gb));
  }
  __syncthreads();
}

DI void p4_sample(const Params& p, int item, char* smem) {
  const int mt = item >> 5, nt = item & 31, lane = threadIdx.x & 63, w = threadIdx.x >> 6, hh = lane >> 5;
  const u16* mg = (const u16*)(p.ws + OFF_X2) + (size_t)(T_P + mt * 32) * 1024;
  float* red = (float*)smem;
  f32x16 a = wgemm32(mg, 1024, (const u16*)(p.ws + OFF_WO) + (size_t)nt * 32 * 1024, 1024, w * 256, w * 256 + 256, lane);
  red_put(a, red, w, lane);
  __syncthreads();
#pragma unroll
  for (int q = 0; q < 4; ++q) {
    const int r = w * 4 + q, srow = mt * 32 + crow(r, hh), col = nt * 32 + (lane & 31);
    p.out[O_YS + (size_t)srow * 1024 + col] = p.x_s[(size_t)srow * 1024 + col] + red_get(red, r, lane);
  }
  __syncthreads();
}

DI void p5_item(const Params& p, int item, float* basep) {
  const int lane = threadIdx.x & 63, w = threadIdx.x >> 6;
  int row = item * 4 + w;
  float4* o = (float4*)(basep + (size_t)row * 1024);
  float4 v[4];
  float ss = 0.f;
#pragma unroll
  for (int i = 0; i < 4; ++i) { v[i] = o[lane + 64 * i]; ss += v[i].x * v[i].x + v[i].y * v[i].y + v[i].z * v[i].z + v[i].w * v[i].w; }
  ss = red64(ss);
  float rs = rsqrtf(ss * (1.f / 1024.f) + 1e-6f);
#pragma unroll
  for (int i = 0; i < 4; ++i) {
    float4 g = ((const float4*)p.fin_g)[lane + 64 * i];
    float4 r; r.x = v[i].x * rs * g.x; r.y = v[i].y * rs * g.y; r.z = v[i].z * rs * g.z; r.w = v[i].w * rs * g.w;
    o[lane + 64 * i] = r;
  }
}

DI void g2img(const u16* __restrict__ src, size_t ld, char* img, int rows) {
  const int t = threadIdx.x, r = t >> 3, ch = t & 7;
  for (int r0 = 0; r0 < rows; r0 += 32) {
    int row = r0 + r;
    *(u32x4*)(img + chunk_off(row, ch)) = *(const u32x4*)(src + (size_t)row * ld + ch * 8);
  }
}
DI void img2g(const char* img, u16* __restrict__ dst, size_t ld, int rows) {
  const int t = threadIdx.x, r = t >> 3, ch = t & 7;
  for (int r0 = 0; r0 < rows; r0 += 32) {
    int row = r0 + r;
    *(u32x4*)(dst + (size_t)row * ld + ch * 8) = *(const u32x4*)(img + chunk_off(row, ch));
  }
}
DI unsigned lds16(const char* img, int row, int k) { return *(const u16*)(img + img_off(row, k)); }

typedef __attribute__((ext_vector_type(4))) short s16x4;
DI void tr_frags4(const char* img, int colbase, int lane, bf16x8 (&f)[4]) {
  const int h = lane >> 5, blk = (lane >> 4) & 1, q = (lane & 15) >> 2, pp = lane & 3;
  const int chunk = (colbase >> 3) + 2 * blk + (pp >> 1);
  const int r0 = 8 * h + q, r1 = r0 + 4;
  const unsigned a0 = (unsigned)(size_t)img + chunk_off(r0, chunk) + 8 * (pp & 1);
  const unsigned a1 = (unsigned)(size_t)img + chunk_off(r1, chunk) + 8 * (pp & 1);
  s16x4 l0, l1, l2, l3, u0, u1, u2, u3;
  asm volatile(
      "ds_read_b64_tr_b16 %0, %8\n\tds_read_b64_tr_b16 %1, %9\n\t"
      "ds_read_b64_tr_b16 %2, %8 offset:2048\n\tds_read_b64_tr_b16 %3, %9 offset:2048\n\t"
      "ds_read_b64_tr_b16 %4, %8 offset:4096\n\tds_read_b64_tr_b16 %5, %9 offset:4096\n\t"
      "ds_read_b64_tr_b16 %6, %8 offset:6144\n\tds_read_b64_tr_b16 %7, %9 offset:6144\n\t"
      "s_waitcnt lgkmcnt(0)"
      : "=&v"(l0), "=&v"(u0), "=&v"(l1), "=&v"(u1), "=&v"(l2), "=&v"(u2), "=&v"(l3), "=&v"(u3)
      : "v"(a0), "v"(a1)
      : "memory");
  f[0] = __builtin_shufflevector(l0, u0, 0, 1, 2, 3, 4, 5, 6, 7);
  f[1] = __builtin_shufflevector(l1, u1, 0, 1, 2, 3, 4, 5, 6, 7);
  f[2] = __builtin_shufflevector(l2, u2, 0, 1, 2, 3, 4, 5, 6, 7);
  f[3] = __builtin_shufflevector(l3, u3, 0, 1, 2, 3, 4, 5, 6, 7);
}

struct GlaPre { u32x4 q0, q1, k0, k1, v0, v1, v2, v3, al; };
DI void p2a_gla_load(const Params& p, int item, GlaPre& R) {
  const int h = item & 3, c = (item >> 2) & 31, b = item >> 7;
  const int t = threadIdx.x, pr = t >> 3, pch = t & 7;
  const u16* proj = (const u16*)(p.ws + OFF_PROJ) + (size_t)(b * 2048 + c * 64) * NP;
  const u16* r0 = proj + (size_t)pr * NP + pch * 8;
  const u16* r1 = r0 + (size_t)32 * NP;
  R.q0 = *(const u32x4*)(r0 + CQ + h * 64); R.q1 = *(const u32x4*)(r1 + CQ + h * 64);
  R.k0 = *(const u32x4*)(r0 + CK + h * 64); R.k1 = *(const u32x4*)(r1 + CK + h * 64);
  R.v0 = *(const u32x4*)(r0 + CV + h * 128); R.v1 = *(const u32x4*)(r1 + CV + h * 128);
  R.v2 = *(const u32x4*)(r0 + CV + h * 128 + 64); R.v3 = *(const u32x4*)(r1 + CV + h * 128 + 64);
  R.al = *(const u32x4*)(proj + (size_t)((t >> 1) & 63) * NP + CAL + (t & 1) * 8);
}

DI void p2a_gla(const Params& p, int item, int next_item, char* smem, GlaPre& R) {
  const int h = item & 3, c = (item >> 2) & 31, b = item >> 7;
  const int t = threadIdx.x, lane = t & 63, w = t >> 6, d = t & 63, tg = w;
  const int tok0 = b * 2048 + c * 64;
  const u16* proj = (const u16*)(p.ws + OFF_PROJ) + (size_t)tok0 * NP;
  u16* qk = (u16*)((char*)p.out + OUTB_QK) + (size_t)tok0 * 512;
  u16* vtg = (u16*)((char*)p.out + OUTB_VT) + (size_t)item * 8192;
  char* Qn = smem;
  char* Kn = smem + 8192;
  char* Vn = smem + 16384;
  char* VT = smem + 32768;
  char* KT = smem + 49152;
  char* al_s = smem + 57344;
  float* tot_s = (float*)(smem + 59392);
  {
    const int pr = t >> 3, pch = t & 7;
    *(u32x4*)(Qn + chunk_off(pr, pch)) = R.q0; *(u32x4*)(Qn + chunk_off(pr + 32, pch)) = R.q1;
    *(u32x4*)(Kn + chunk_off(pr, pch)) = R.k0; *(u32x4*)(Kn + chunk_off(pr + 32, pch)) = R.k1;
    *(u32x4*)(Vn + chunk_off(pr, pch)) = R.v0; *(u32x4*)(Vn + chunk_off(pr + 32, pch)) = R.v1;
    *(u32x4*)(Vn + 8192 + chunk_off(pr, pch)) = R.v2; *(u32x4*)(Vn + 8192 + chunk_off(pr + 32, pch)) = R.v3;
    if (t < 128) *(u32x4*)(al_s + (t >> 1) * 32 + (t & 1) * 16) = R.al;
    if (next_item < 1024) p2a_gla_load(p, next_item, R);
  }
  float wa[16];
#pragma unroll
  for (int r = 0; r < 16; ++r) wa[r] = p.w_a2[r * 256 + h * 64 + d];
  const float bias = p.b_a2[h * 64 + d];
  __syncthreads();
  float bl[16];
  float run = 0.f;
#pragma unroll
  for (int jj = 0; jj < 16; ++jj) {
    const char* al = al_s + (tg * 16 + jj) * 32;
    u32x4 a0 = *(const u32x4*)al, a1 = *(const u32x4*)(al + 16);
    float x = bias;
#pragma unroll
    for (int q = 0; q < 4; ++q) {
      x += bflo(a0[q]) * wa[2 * q] + bfhi(a0[q]) * wa[2 * q + 1];
      x += bflo(a1[q]) * wa[8 + 2 * q] + bfhi(a1[q]) * wa[8 + 2 * q + 1];
    }
    run += logsig(x) * (1.f / 16.f);
    bl[jj] = run;
  }
  tot_s[tg * 64 + d] = run;
  __syncthreads();
  float off = 0.f;
#pragma unroll
  for (int g = 0; g < 4; ++g) off += (g < tg) ? tot_s[g * 64 + d] : 0.f;
#pragma unroll
  for (int jj = 0; jj < 16; ++jj) {
    const int j = tg * 16 + jj;
    const float bb = bl[jj] + off;
    u16* qp = (u16*)(Qn + img_off(j, d));
    u16* kp = (u16*)(Kn + img_off(j, d));
    const float eb = __expf(bb);
    *qp = f2bf(bf2f(*qp) * 0.125f * eb);
    *kp = f2bf(bf2f(*kp) * __builtin_amdgcn_rcpf(eb));
  }
  __syncthreads();
  img2g(Qn, qk + h * 64, 512, 64);
  img2g(Kn, qk + 256 + h * 64, 512, 64);
  const int dcol = lane & 31, hh = lane >> 5;
  float* gdec = (float*)(p.ws + OFF_GG) + (size_t)((b * 32 + c) * 4 + h) * 64;
  bf16x8 vfr[4];
  tr_frags4(Vn + (w >> 1) * 8192, (w & 1) * 32, lane, vfr);
#pragma unroll
  for (int dt = 0; dt < 2; ++dt) {
    f32x16 acc = zero16();
    bf16x8 kfr[4];
    tr_frags4(Kn, dt * 32, lane, kfr);
#pragma unroll
    for (int ks = 0; ks < 4; ++ks) acc = MFMA(vfr[ks], kfr[ks], acc);
    int dd = dt * 32 + dcol;
    float gd = __expf(tot_s[dd] + tot_s[64 + dd] + tot_s[128 + dd] + tot_s[192 + dd]);
    if (w == 0 && hh == 0) gdec[dd] = gd;
#pragma unroll
    for (int r = 0; r < 16; ++r) *(u16*)(VT + img_off(w * 32 + crow(r, hh), dd)) = f2bf(acc[r] * gd);
  }
  __syncthreads();
  img2g(VT, (u16*)(p.ws + OFF_X1) + (size_t)((b * 32 + c) * 4 + h) * 8192, 64, 128);
  __syncthreads();
}

DI void p2a_ssd(const Params& p, int item, char* smem) {
  const int pair = item & 1, grp = (item >> 1) & 1, c = (item >> 2) & 31, b = item >> 7;
  const int t = threadIdx.x, lane = t & 63, w = t >> 6;
  const int tok0 = b * 2048 + c * 64;
  const u16* proj = (const u16*)(p.ws + OFF_PROJ) + (size_t)tok0 * NP;
  u16* xbcc = (u16*)((char*)p.out + OUTB_XBCC) + (size_t)tok0 * 768;
  char* Xn = smem;
  char* Bn = smem + 16384;
  char* XT = smem + 24576;
  char* BT = smem + 40960;
  float* sc_s = (float*)(smem + 49152);
  if (w < 2) {
    int hd = grp * 4 + pair * 2 + w, tok = tok0 + lane;
    float dt = softplus(bf2f(proj[(size_t)lane * NP + CDT + hd]) + p.dt_bias[hd]);
    float cum = -__expf(p.a_log[hd]) * dt;
#pragma unroll
    for (int o = 1; o < 64; o <<= 1) { float n = __shfl_up(cum, o); if (lane >= o) cum += n; }
    float clast = __shfl(cum, 63);
    ((float*)(p.ws + OFF_DT))[(size_t)tok * 8 + hd] = dt;
    ((float*)(p.ws + OFF_CUM))[(size_t)tok * 8 + hd] = cum;
    sc_s[w * 64 + lane] = dt * __expf(clast - cum);
    if (lane == 63) ((float*)(p.ws + OFF_GS))[(b * 32 + c) * 8 + hd] = __expf(clast);
  }
  {
    const int o = t & 31;
    const int ch = o < 16 ? grp * 256 + pair * 128 + o * 8 : (o < 24 ? 512 + grp * 64 + (o - 16) * 8 : 640 + grp * 64 + (o - 24) * 8);
    float cw[4][8], cb[8];
#pragma unroll
    for (int k = 0; k < 4; ++k) {
      float4 a = *(const float4*)(p.conv_w + k * 768 + ch), bb = *(const float4*)(p.conv_w + k * 768 + ch + 4);
      cw[k][0] = a.x; cw[k][1] = a.y; cw[k][2] = a.z; cw[k][3] = a.w; cw[k][4] = bb.x; cw[k][5] = bb.y; cw[k][6] = bb.z; cw[k][7] = bb.w;
    }
    {
      float4 a = *(const float4*)(p.conv_b + ch), bb = *(const float4*)(p.conv_b + ch + 4);
      cb[0] = a.x; cb[1] = a.y; cb[2] = a.z; cb[3] = a.w; cb[4] = bb.x; cb[5] = bb.y; cb[6] = bb.z; cb[7] = bb.w;
    }
    const bool store_g = (o < 16) || (o < 24 ? pair == 0 : pair == 1);
    const int j0 = (t >> 5) * 8;
    u32x4 xr[11];
#pragma unroll
    for (int r = 0; r < 11; ++r) {
      const int jr = j0 - 3 + r;
      if (jr >= 0 || c > 0) xr[r] = *(const u32x4*)(proj + (ptrdiff_t)jr * NP + CX + ch);
      else { xr[r][0] = 0u; xr[r][1] = 0u; xr[r][2] = 0u; xr[r][3] = 0u; }
    }
#pragma unroll
    for (int i = 0; i < 8; ++i) {
      const int j = j0 + i;
      float s[8];
#pragma unroll
      for (int q = 0; q < 8; ++q) s[q] = cb[q];
#pragma unroll
      for (int k = 0; k < 4; ++k) {
#pragma unroll
        for (int q = 0; q < 4; ++q) { s[2 * q] += bflo(xr[i + k][q]) * cw[k][2 * q]; s[2 * q + 1] += bfhi(xr[i + k][q]) * cw[k][2 * q + 1]; }
      }
      u32x4 ov;
#pragma unroll
      for (int q = 0; q < 4; ++q) ov[q] = pack2(silu(s[2 * q]), silu(s[2 * q + 1]));
      if (store_g) *(u32x4*)(xbcc + (size_t)j * 768 + ch) = ov;
      if (o < 16) *(u32x4*)(Xn + (o >> 3) * 8192 + chunk_off(j, o & 7)) = ov;
      else if (o < 24) *(u32x4*)(Bn + chunk_off(j, o - 16)) = ov;
    }
  }
  __syncthreads();
  {
    const int row = t & 127, half = t >> 7, hl = row >> 6, pp = row & 63;
    const char* ximg = Xn + hl * 8192;
#pragma unroll
    for (int cc = 0; cc < 4; ++cc) {
      int ch = half * 4 + cc;
      u32x4 v;
#pragma unroll
      for (int q = 0; q < 4; ++q) {
        int j0 = ch * 8 + 2 * q;
        v[q] = pack2(bf2f(lds16(ximg, j0, pp)) * sc_s[hl * 64 + j0], bf2f(lds16(ximg, j0 + 1, pp)) * sc_s[hl * 64 + j0 + 1]);
      }
      *(u32x4*)(XT + chunk_off(row, ch)) = v;
    }
    const int n = t & 63, qq = t >> 6;
#pragma unroll
    for (int cc = 0; cc < 2; ++cc) {
      int ch = qq * 2 + cc;
      u32x4 v;
#pragma unroll
      for (int q = 0; q < 4; ++q) v[q] = lds16(Bn, ch * 8 + 2 * q, n) | (lds16(Bn, ch * 8 + 2 * q + 1, n) << 16);
      *(u32x4*)(BT + chunk_off(n, ch)) = v;
    }
  }
  __syncthreads();
  {
    const int hl = w >> 1, pt = w & 1, hh = lane >> 5;
#pragma unroll
    for (int nt = 0; nt < 2; ++nt) {
      f32x16 acc = zero16();
      mma64(acc, XT, hl * 64 + pt * 32, BT, nt * 32, lane);
#pragma unroll
      for (int r = 0; r < 16; ++r) *(u16*)(Xn + hl * 8192 + img_off(pt * 32 + crow(r, hh), nt * 32 + (lane & 31))) = f2bf(acc[r]);
    }
  }
  if (c == 31) {
    for (int i = t; i < 3 * 192; i += 256) {
      int r = i / 192, q = i - r * 192;
      int ch = q < 128 ? grp * 256 + pair * 128 + q : (pair == 0 ? 512 : 640) + grp * 64 + (q - 128);
      p.out[O_CONVP + (size_t)(b * 3 + r) * 768 + ch] = bf2f(proj[(size_t)(61 + r) * NP + CX + ch]);
    }
  }
  __syncthreads();
  img2g(Xn, (u16*)(p.ws + OFF_X1 + 16777216) + (size_t)((b * 32 + c) * 8 + grp * 4 + pair * 2) * 4096, 64, 128);
  __syncthreads();
}

DI void p2a_gla_sample(const Params& p, int item, char* smem) {
  const int h = item & 3, s = item >> 2, tok = T_P + s;
  const int t = threadIdx.x, lane = t & 63, w = t >> 6;
  const u16* proj = (const u16*)(p.ws + OFF_PROJ) + (size_t)tok * NP;
  float* g_s = (float*)smem;
  float* q_s = g_s + 64;
  float* k_s = q_s + 64;
  float* v_s = k_s + 64;
  float* op_s = v_s + 128;
  float* red_s = op_s + 1024;
  if (t < 64) {
    float x = p.b_a2[h * 64 + t];
#pragma unroll
    for (int r = 0; r < 16; ++r) x += bf2f(proj[CAL + r]) * p.w_a2[r * 256 + h * 64 + t];
    g_s[t] = expf(logsig(x) * (1.f / 16.f));
    q_s[t] = bf2f(proj[CQ + h * 64 + t]) * 0.125f;
    k_s[t] = bf2f(proj[CK + h * 64 + t]);
  } else if (t < 192) v_s[t - 64] = bf2f(proj[CV + h * 128 + (t - 64)]);
  __syncthreads();
  const int e0 = (t & 31) * 4, dq = t >> 5;
  const float* S0 = p.st_gla + (size_t)(s * 4 + h) * 8192 + e0;
  float* So = p.out + O_GLAS + (size_t)(s * 4 + h) * 8192 + e0;
  const float4 ve = *(const float4*)(v_s + e0);
  float4 sv[8];
#pragma unroll
  for (int dd = 0; dd < 8; ++dd) sv[dd] = *(const float4*)(S0 + (size_t)(dq * 8 + dd) * 128);
  float4 op; op.x = 0.f; op.y = 0.f; op.z = 0.f; op.w = 0.f;
#pragma unroll
  for (int dd = 0; dd < 8; ++dd) {
    const int d = dq * 8 + dd;
    const float g = g_s[d], kd = k_s[d], qd = q_s[d];
    float4 sn;
    sn.x = g * sv[dd].x + kd * ve.x; sn.y = g * sv[dd].y + kd * ve.y; sn.z = g * sv[dd].z + kd * ve.z; sn.w = g * sv[dd].w + kd * ve.w;
    *(float4*)(So + (size_t)d * 128) = sn;
    op.x += qd * sn.x; op.y += qd * sn.y; op.z += qd * sn.z; op.w += qd * sn.w;
  }
  *(float4*)(op_s + dq * 128 + e0) = op;
  __syncthreads();
  float o = 0.f;
  if (t < 128) {
#pragma unroll
    for (int q = 0; q < 8; ++q) o += op_s[q * 128 + t];
  }
  float ss = red64(o * o);
  if (lane == 0) red_s[w] = ss;
  __syncthreads();
  if (t < 128) {
    float rs = rsqrtf((red_s[0] + red_s[1]) * (1.f / 128.f) + 1e-6f);
    float gg = bf2f(proj[CG + h * 128 + t]);
    u16* U = (u16*)(p.ws + OFF_X1) + (size_t)tok * 1024;
    U[h * 128 + t] = f2bf(o * rs * p.gla_ng[h * 128 + t] * silu(gg));
  }
  __syncthreads();
}

DI void p2a_gla_sample2(const Params& p, int pi, char* smem) {
  const int s = pi >> 1, h0 = (pi & 1) * 2, tok = T_P + s;
  const int t = threadIdx.x, lane = t & 63, w = t >> 6;
  const u16* proj = (const u16*)(p.ws + OFF_PROJ) + (size_t)tok * NP;
  float* g_s = (float*)smem;
  float* q_s = g_s + 128;
  float* k_s = q_s + 128;
  float* v_s = k_s + 128;
  float* op_s = v_s + 256;
  float* red_s = op_s + 2048;
  const int e0 = (t & 31) * 4, dq = t >> 5;
  float4 sv[2][8];
#pragma unroll
  for (int hh = 0; hh < 2; ++hh) {
    const float* S0 = p.st_gla + (size_t)(s * 4 + h0 + hh) * 8192 + e0;
#pragma unroll
    for (int dd = 0; dd < 8; ++dd) sv[hh][dd] = *(const float4*)(S0 + (size_t)(dq * 8 + dd) * 128);
  }
  if (t < 128) {
    const int hh = t >> 6, d = t & 63, h = h0 + hh;
    float x = p.b_a2[h * 64 + d];
#pragma unroll
    for (int r = 0; r < 16; ++r) x += bf2f(proj[CAL + r]) * p.w_a2[r * 256 + h * 64 + d];
    g_s[t] = expf(logsig(x) * (1.f / 16.f));
    q_s[t] = bf2f(proj[CQ + h * 64 + d]) * 0.125f;
    k_s[t] = bf2f(proj[CK + h * 64 + d]);
  }
  v_s[t] = bf2f(proj[CV + h0 * 128 + t]);
  __syncthreads();
#pragma unroll
  for (int hh = 0; hh < 2; ++hh) {
    float* So = p.out + O_GLAS + (size_t)(s * 4 + h0 + hh) * 8192 + e0;
    const float4 ve = *(const float4*)(v_s + hh * 128 + e0);
    float4 op; op.x = 0.f; op.y = 0.f; op.z = 0.f; op.w = 0.f;
#pragma unroll
    for (int dd = 0; dd < 8; ++dd) {
      const int d = dq * 8 + dd;
      const float g = g_s[hh * 64 + d], kd = k_s[hh * 64 + d], qd = q_s[hh * 64 + d];
      float4 sn;
      sn.x = g * sv[hh][dd].x + kd * ve.x; sn.y = g * sv[hh][dd].y + kd * ve.y; sn.z = g * sv[hh][dd].z + kd * ve.z; sn.w = g * sv[hh][dd].w + kd * ve.w;
      *(float4*)(So + (size_t)d * 128) = sn;
      op.x += qd * sn.x; op.y += qd * sn.y; op.z += qd * sn.z; op.w += qd * sn.w;
    }
    *(float4*)(op_s + (hh * 8 + dq) * 128 + e0) = op;
  }
  __syncthreads();
  const int hh = t >> 7, e = t & 127;
  float o = 0.f;
#pragma unroll
  for (int q = 0; q < 8; ++q) o += op_s[(hh * 8 + q) * 128 + e];
  float ss = red64(o * o);
  if (lane == 0) red_s[w] = ss;
  __syncthreads();
  {
    const float rs = rsqrtf((red_s[2 * hh] + red_s[2 * hh + 1]) * (1.f / 128.f) + 1e-6f);
    const int col = (h0 + hh) * 128 + e;
    const float gg = bf2f(proj[CG + col]);
    u16* U = (u16*)(p.ws + OFF_X1) + (size_t)tok * 1024;
    U[col] = f2bf(o * rs * p.gla_ng[col] * silu(gg));
  }
  __syncthreads();
}

DI void p2a_ssd_sample(const Params& p, int item, char* smem) {
  const int grp = item & 1, s = item >> 1, tok = T_P + s;
  const int t = threadIdx.x, lane = t & 63, w = t >> 6;
  const u16* proj = (const u16*)(p.ws + OFF_PROJ) + (size_t)tok * NP;
  float* x_s = (float*)smem;
  float* B_s = x_s + 256;
  float* C_s = B_s + 64;
  float* y_s = C_s + 64;
  float* red_s = y_s + 256;
  for (int i = t; i < 384; i += 256) {
    int ch = i < 256 ? grp * 256 + i : (i < 320 ? 512 + grp * 64 + (i - 256) : 640 + grp * 64 + (i - 320));
    const float* buf = p.st_conv + (size_t)s * 3 * 768;
    float b0 = buf[ch], b1 = buf[768 + ch], b2 = buf[1536 + ch], u = bf2f(proj[CX + ch]);
    float sv = p.conv_b[ch] + b0 * p.conv_w[ch] + b1 * p.conv_w[768 + ch] + b2 * p.conv_w[1536 + ch] + u * p.conv_w[2304 + ch];
    x_s[i] = silu(sv);
    float* co = p.out + O_CONVS + (size_t)s * 3 * 768;
    co[ch] = b1; co[768 + ch] = b2; co[1536 + ch] = u;
  }
  __syncthreads();
  const int pp = t >> 2, nq = t & 3;
  float ssq = 0.f;
#pragma unroll
  for (int hl = 0; hl < 4; ++hl) {
    int hd = grp * 4 + hl;
    float dt = softplus(bf2f(proj[CDT + hd]) + p.dt_bias[hd]);
    float dA = expf(-expf(p.a_log[hd]) * dt);
    float xv = x_s[hl * 64 + pp];
    const float4* h0 = (const float4*)(p.st_ssm + (size_t)((s * 8 + hd) * 64 + pp) * 64 + nq * 16);
    float4* ho = (float4*)(p.out + O_SSMS + (size_t)((s * 8 + hd) * 64 + pp) * 64 + nq * 16);
    float yp = 0.f, dx = dt * xv;
#pragma unroll
    for (int q = 0; q < 4; ++q) {
      float4 hv = h0[q];
      int n = nq * 16 + q * 4;
      hv.x = dA * hv.x + dx * B_s[n]; hv.y = dA * hv.y + dx * B_s[n + 1]; hv.z = dA * hv.z + dx * B_s[n + 2]; hv.w = dA * hv.w + dx * B_s[n + 3];
      ho[q] = hv;
      yp += hv.x * C_s[n] + hv.y * C_s[n + 1] + hv.z * C_s[n + 2] + hv.w * C_s[n + 3];
    }
    yp += __shfl_xor(yp, 1);
    yp += __shfl_xor(yp, 2);
    float z = bf2f(proj[CZ + grp * 256 + hl * 64 + pp]);
    float y = (yp + p.d_skip[hd] * xv) * silu(z);
    if (nq == 0) { y_s[hl * 64 + pp] = y; ssq += y * y; }
  }
  ssq = red64(ssq);
  if (lane == 0) red_s[w] = ssq;
  __syncthreads();
  {
    float rs = rsqrtf((red_s[0] + red_s[1] + red_s[2] + red_s[3]) * (1.f / 256.f) + 1e-6f);
    u16* U = (u16*)(p.ws + OFF_X1) + (size_t)tok * 1024;
    U[512 + grp * 256 + t] = f2bf(y_s[t] * rs * p.ssd_ng[grp * 256 + t]);
  }
  __syncthreads();
}

DI void p2b_item(const Params& p, int item) {
  const int t = threadIdx.x;
  if (item < 256) {
    const int gid = item * 256 + t;
    const int dq = gid & 15, e = (gid >> 4) & 127, h = (gid >> 11) & 3, b = gid >> 13;
    const u16* dS = (const u16*)(p.ws + OFF_X1);
    u16* Sp = (u16*)(p.ws + OFF_X2);
    const float* gg = (const float*)(p.ws + OFF_GG);
    float S0 = 0.f, S1 = 0.f, S2 = 0.f, S3 = 0.f;
#pragma unroll 16
    for (int c = 0; c < 32; ++c) {
      const size_t base = ((size_t)((b * 32 + c) * 4 + h) * 128 + e) * 64 + dq * 4;
      uint2 o; o.x = pack2(S0, S1); o.y = pack2(S2, S3);
      *(uint2*)(Sp + base) = o;
      const uint2 ds = *(const uint2*)(dS + base);
      const float4 g = *(const float4*)(gg + ((b * 32 + c) * 4 + h) * 64 + dq * 4);
      S0 = g.x * S0 + bflo(ds.x);
      S1 = g.y * S1 + bfhi(ds.x);
      S2 = g.z * S2 + bflo(ds.y);
      S3 = g.w * S3 + bfhi(ds.y);
    }
    float* o = p.out + O_GLAP + (size_t)((b * 4 + h) * 64 + dq * 4) * 128 + e;
    o[0] = S0; o[128] = S1; o[256] = S2; o[384] = S3;
  } else {
    const int gid = (item - 256) * 256 + t;
    const int nq = gid & 15, pp = (gid >> 4) & 63, hd = (gid >> 10) & 7, b = gid >> 13;
    const u16* dh = (const u16*)(p.ws + OFF_X1 + 16777216);
    u16* hp = (u16*)(p.ws + OFF_X2 + 16777216);
    const float* gs = (const float*)(p.ws + OFF_GS);
    float h0 = 0.f, h1 = 0.f, h2 = 0.f, h3 = 0.f;
#pragma unroll 16
    for (int c = 0; c < 32; ++c) {
      const size_t base = ((size_t)((b * 32 + c) * 8 + hd) * 64 + pp) * 64 + nq * 4;
      uint2 o; o.x = pack2(h0, h1); o.y = pack2(h2, h3);
      *(uint2*)(hp + base) = o;
      const uint2 dv = *(const uint2*)(dh + base);
      const float g = gs[(b * 32 + c) * 8 + hd];
      h0 = g * h0 + bflo(dv.x);
      h1 = g * h1 + bfhi(dv.x);
      h2 = g * h2 + bflo(dv.y);
      h3 = g * h3 + bfhi(dv.y);
    }
    float4 r; r.x = h0; r.y = h1; r.z = h2; r.w = h3;
    *(float4*)(p.out + O_SSMP + (size_t)((b * 8 + hd) * 64 + pp) * 64 + nq * 4) = r;
  }
}

struct GlcPre { u32x4 q0, q1, k0, k1, vt0, vt1, vt2, vt3, g0, g1, g2, g3; bf16x8 sf[4]; };
DI void p2c_gla_load(const Params& p, int item, GlcPre& R) {
  const int h = item & 3, c = (item >> 2) & 31, b = item >> 7;
  const int t = threadIdx.x, lane = t & 63, w = t >> 6, hh = lane >> 5, pr = t >> 3, pch = t & 7;
  const int tok0 = b * 2048 + c * 64;
  const u16* qk = (const u16*)((const char*)p.out + OUTB_QK) + (size_t)(tok0 + pr) * 512 + pch * 8;
  const u16* gp = (const u16*)(p.ws + OFF_PROJ) + (size_t)(tok0 + pr) * NP + CG + h * 128 + pch * 8;
  R.q0 = *(const u32x4*)(qk + h * 64); R.q1 = *(const u32x4*)(qk + (size_t)32 * 512 + h * 64);
  R.k0 = *(const u32x4*)(qk + 256 + h * 64); R.k1 = *(const u32x4*)(qk + (size_t)32 * 512 + 256 + h * 64);
  const u16* vp = (const u16*)(p.ws + OFF_PROJ) + (size_t)(tok0 + pr) * NP + CV + h * 128 + pch * 8;
  R.vt0 = *(const u32x4*)vp; R.vt1 = *(const u32x4*)(vp + (size_t)32 * NP); R.vt2 = *(const u32x4*)(vp + 64); R.vt3 = *(const u32x4*)(vp + (size_t)32 * NP + 64);
  R.g0 = *(const u32x4*)gp; R.g1 = *(const u32x4*)(gp + (size_t)32 * NP); R.g2 = *(const u32x4*)(gp + 64); R.g3 = *(const u32x4*)(gp + (size_t)32 * NP + 64);
  const u16* Sp = (const u16*)(p.ws + OFF_X2) + (size_t)((b * 32 + c) * 4 + h) * 8192;
#pragma unroll
  for (int ks = 0; ks < 4; ++ks) R.sf[ks] = *(const bf16x8*)(Sp + (w * 32 + (lane & 31)) * 64 + (ks * 2 + hh) * 8);
}

DI void p2c_gla(const Params& p, int item, int next_item, char* smem, GlcPre& R) {
  const int h = item & 3, c = (item >> 2) & 31, b = item >> 7;
  const int t = threadIdx.x, lane = t & 63, w = t >> 6, hh = lane >> 5;
  const int tok0 = b * 2048 + c * 64;
  const u16* proj = (const u16*)(p.ws + OFF_PROJ) + (size_t)tok0 * NP;
  const u16* qk = (const u16*)((const char*)p.out + OUTB_QK) + (size_t)tok0 * 512;
  const u16* vtg = (const u16*)((const char*)p.out + OUTB_VT) + (size_t)item * 8192;
  char* Q = smem;
  char* Kt = smem + 8192;
  char* VT = smem + 16384;
  char* Aimg = smem + 32768;
  char* Gn = smem + 40960;
  float* part_s = (float*)(smem + 57344);
  bf16x8 sfrag[4];
  {
    const int pr = t >> 3, pch = t & 7;
    *(u32x4*)(Q + chunk_off(pr, pch)) = R.q0; *(u32x4*)(Q + chunk_off(pr + 32, pch)) = R.q1;
    *(u32x4*)(Kt + chunk_off(pr, pch)) = R.k0; *(u32x4*)(Kt + chunk_off(pr + 32, pch)) = R.k1;
    *(u32x4*)(VT + chunk_off(pr, pch)) = R.vt0; *(u32x4*)(VT + chunk_off(pr + 32, pch)) = R.vt1;
    *(u32x4*)(VT + 8192 + chunk_off(pr, pch)) = R.vt2; *(u32x4*)(VT + 8192 + chunk_off(pr + 32, pch)) = R.vt3;
    *(u32x4*)(Gn + chunk_off(pr, pch)) = R.g0; *(u32x4*)(Gn + chunk_off(pr + 32, pch)) = R.g1;
    *(u32x4*)(Gn + 8192 + chunk_off(pr, pch)) = R.g2; *(u32x4*)(Gn + 8192 + chunk_off(pr + 32, pch)) = R.g3;
#pragma unroll
    for (int ks = 0; ks < 4; ++ks) sfrag[ks] = R.sf[ks];
    if (next_item < 1024) p2c_gla_load(p, next_item, R);
  }
  __syncthreads();
  {
    const int it = w >> 1, jt = w & 1;
    f32x16 a = zero16();
    mma64(a, Q, it * 32, Kt, jt * 32, lane);
#pragma unroll
    for (int r = 0; r < 16; ++r) {
      int i = it * 32 + crow(r, hh), j = jt * 32 + (lane & 31);
      *(u16*)(Aimg + img_off(i, j)) = f2bf(i >= j ? a[r] : 0.f);
    }
  }
  __syncthreads();
  f32x16 acc[2];
  bf16x8 vfr[4];
  tr_frags4(VT + (w >> 1) * 8192, (w & 1) * 32, lane, vfr);
#pragma unroll
  for (int it = 0; it < 2; ++it) {
    acc[it] = zero16();
#pragma unroll
    for (int ks = 0; ks < 4; ++ks) {
      acc[it] = MFMA(frag(Aimg, it * 32, ks, lane), vfr[ks], acc[it]);
      acc[it] = MFMA(frag(Q, it * 32, ks, lane), sfrag[ks], acc[it]);
    }
#pragma unroll
    for (int r = 0; r < 16; ++r) {
      float ss = red32(acc[it][r] * acc[it][r]);
      if ((lane & 31) == 0) part_s[w * 64 + it * 32 + crow(r, hh)] = ss;
    }
  }
  __syncthreads();
  const int e = w * 32 + (lane & 31);
  const float gn = p.gla_ng[h * 128 + e];
  char* gimg = Gn + (w >> 1) * 8192;
  const int ec = (w & 1) * 32 + (lane & 31);
#pragma unroll
  for (int it = 0; it < 2; ++it)
#pragma unroll
    for (int r = 0; r < 16; ++r) {
      int i = it * 32 + crow(r, hh);
      float rs = rsqrtf((part_s[i] + part_s[64 + i] + part_s[128 + i] + part_s[192 + i]) * (1.f / 128.f) + 1e-6f);
      u16* gp = (u16*)(gimg + img_off(i, ec));
      *gp = f2bf(acc[it][r] * rs * gn * silu(bf2f(*gp)));
    }
  __syncthreads();
  u16* U = (u16*)(p.ws + OFF_X1) + (size_t)tok0 * 1024 + h * 128;
  img2g(Gn, U, 1024, 64);
  img2g(Gn + 8192, U + 64, 1024, 64);
  __syncthreads();
}

DI void p2c_ssd(const Params& p, int item, char* smem) {
  const int grp = item & 1, c = (item >> 1) & 31, b = item >> 6;
  const int t = threadIdx.x, lane = t & 63, w = t >> 6, hh = lane >> 5;
  const int tok0 = b * 2048 + c * 64;
  const u16* proj = (const u16*)(p.ws + OFF_PROJ) + (size_t)tok0 * NP;
  const u16* xbcc = (const u16*)((const char*)p.out + OUTB_XBCC) + (size_t)tok0 * 768;
  u16* U = (u16*)(p.ws + OFF_X1) + (size_t)tok0 * 1024 + 512 + grp * 256;
  char* Cimg = smem;
  char* Bimg = smem + 8192;
  char* Xn = smem + 16384;
  char* Ximg = smem + 24576;
  char* Simg = smem + 32768;
  char* Zn = smem + 40960;
  float* cum_s = (float*)(smem + 49152);
  float* dt_s = cum_s + 256;
  float* part_s = dt_s + 256;
  g2img(xbcc + 640 + grp * 64, 768, Cimg, 64);
  g2img(xbcc + 512 + grp * 64, 768, Bimg, 64);
  cum_s[t] = ((const float*)(p.ws + OFF_CUM))[(size_t)(tok0 + (t & 63)) * 8 + grp * 4 + (t >> 6)];
  dt_s[t] = ((const float*)(p.ws + OFF_DT))[(size_t)(tok0 + (t & 63)) * 8 + grp * 4 + (t >> 6)];
  __syncthreads();
  const int it = w >> 1, pt = w & 1;
  f32x16 cb = zero16();
  mma64(cb, Cimg, it * 32, Bimg, pt * 32, lane);
  f32x16 ssq = zero16();
  const int pr = t >> 3, pch = t & 7;
  u32x4 xr0, xr1, zr0, zr1;
  bf16x8 hfn[4];
#define LOADH(hl_) do { \
    const u16* xs_ = xbcc + grp * 256 + (hl_) * 64 + (size_t)pr * 768 + pch * 8; \
    const u16* zs_ = proj + CZ + grp * 256 + (hl_) * 64 + (size_t)pr * NP + pch * 8; \
    xr0 = *(const u32x4*)xs_; xr1 = *(const u32x4*)(xs_ + (size_t)32 * 768); \
    zr0 = *(const u32x4*)zs_; zr1 = *(const u32x4*)(zs_ + (size_t)32 * NP); \
    const u16* hp_ = (const u16*)(p.ws + OFF_X2 + 16777216) + (size_t)((b * 32 + c) * 8 + grp * 4 + (hl_)) * 4096; \
    _Pragma("unroll") for (int ks = 0; ks < 4; ++ks) hfn[ks] = *(const bf16x8*)(hp_ + (pt * 32 + (lane & 31)) * 64 + (ks * 2 + hh) * 8); } while (0)
  LOADH(0);
#pragma unroll 1
  for (int hl = 0; hl < 4; ++hl) {
    const int hd = grp * 4 + hl;
    *(u32x4*)(Xn + chunk_off(pr, pch)) = xr0; *(u32x4*)(Xn + chunk_off(pr + 32, pch)) = xr1;
    *(u32x4*)(Zn + chunk_off(pr, pch)) = zr0; *(u32x4*)(Zn + chunk_off(pr + 32, pch)) = zr1;
    bf16x8 hf[4];
#pragma unroll
    for (int ks = 0; ks < 4; ++ks) hf[ks] = hfn[ks];
    if (hl < 3) LOADH(hl + 1);
#pragma unroll
    for (int r = 0; r < 16; ++r) {
      int i = it * 32 + crow(r, hh), j = pt * 32 + (lane & 31);
      float sv = i >= j ? cb[r] * __expf(cum_s[hl * 64 + i] - cum_s[hl * 64 + j]) : 0.f;
      *(u16*)(Simg + img_off(i, j)) = f2bf(sv);
    }
    __syncthreads();
    {
      const int pp = t & 63, qq = t >> 6;
#pragma unroll
      for (int cc = 0; cc < 2; ++cc) {
        int ch = qq * 2 + cc;
        u32x4 v;
#pragma unroll
        for (int q = 0; q < 4; ++q) {
          int j0 = ch * 8 + 2 * q;
          v[q] = pack2(bf2f(lds16(Xn, j0, pp)) * dt_s[hl * 64 + j0], bf2f(lds16(Xn, j0 + 1, pp)) * dt_s[hl * 64 + j0 + 1]);
        }
        *(u32x4*)(Ximg + chunk_off(pp, ch)) = v;
      }
    }
    __syncthreads();
    f32x16 y = zero16();
#pragma unroll
    for (int ks = 0; ks < 4; ++ks) y = MFMA(frag(Cimg, it * 32, ks, lane), hf[ks], y);
#pragma unroll
    for (int r = 0; r < 16; ++r) y[r] *= __expf(cum_s[hl * 64 + it * 32 + crow(r, hh)]);
    mma64(y, Simg, it * 32, Ximg, pt * 32, lane);
    const float dsk = p.d_skip[hd];
    const int pc = pt * 32 + (lane & 31);
#pragma unroll
    for (int r = 0; r < 16; ++r) {
      int i = it * 32 + crow(r, hh);
      float xs = bf2f(lds16(Xn, i, pc));
      u16* zp = (u16*)(Zn + img_off(i, pc));
      u16 yb = f2bf((y[r] + dsk * xs) * silu(bf2f(*zp)));
      *zp = yb;
      float yo = bf2f(yb);
      ssq[r] += yo * yo;
    }
    __syncthreads();
    img2g(Zn, U + hl * 64, 1024, 64);
    __syncthreads();
  }
#undef LOADH
#pragma unroll
  for (int r = 0; r < 16; ++r) {
    float ss = red32(ssq[r]);
    if ((lane & 31) == 0) part_s[pt * 64 + it * 32 + crow(r, hh)] = ss;
  }
  __syncthreads();
  {
    const int r = t >> 3, ch = t & 7;
    u32x4 uv[4][2];
    float4 ga[4], gb[4];
#pragma unroll
    for (int hl = 0; hl < 4; ++hl) {
      ga[hl] = *(const float4*)(p.ssd_ng + grp * 256 + hl * 64 + ch * 8);
      gb[hl] = *(const float4*)(p.ssd_ng + grp * 256 + hl * 64 + ch * 8 + 4);
#pragma unroll
      for (int i2 = 0; i2 < 2; ++i2) uv[hl][i2] = *(const u32x4*)(U + (size_t)(r + 32 * i2) * 1024 + hl * 64 + ch * 8);
    }
    const float rs0 = rsqrtf((part_s[r] + part_s[64 + r]) * (1.f / 256.f) + 1e-6f);
    const float rs1 = rsqrtf((part_s[r + 32] + part_s[64 + r + 32]) * (1.f / 256.f) + 1e-6f);
#pragma unroll
    for (int hl = 0; hl < 4; ++hl)
#pragma unroll
      for (int i2 = 0; i2 < 2; ++i2) {
        const float rs = i2 ? rs1 : rs0;
        u32x4 v = uv[hl][i2];
        v[0] = pack2(bflo(v[0]) * rs * ga[hl].x, bfhi(v[0]) * rs * ga[hl].y);
        v[1] = pack2(bflo(v[1]) * rs * ga[hl].z, bfhi(v[1]) * rs * ga[hl].w);
        v[2] = pack2(bflo(v[2]) * rs * gb[hl].x, bfhi(v[2]) * rs * gb[hl].y);
        v[3] = pack2(bflo(v[3]) * rs * gb[hl].z, bfhi(v[3]) * rs * gb[hl].w);
        *(u32x4*)(U + (size_t)(r + 32 * i2) * 1024 + hl * 64 + ch * 8) = v;
      }
  }
  __syncthreads();
}

#define XB_TMO      128
#define XB_XCNT(j)  (256  + 64 * (j))
#define XB_XSUB(j)  (1280 + 64 * (j))
#define XB_XGEN(j)  (2304 + 64 * (j))
#define XB_TOP      3328
#define XB_TOPGEN   3392
#define XCD_BAR_WORDS 3456
#define XB_SPIN_CAP (1u << 20)
#define LAS __attribute__((address_space(3)))
DI unsigned xb_ld(unsigned* p) { return __hip_atomic_load(p, __ATOMIC_RELAXED, __HIP_MEMORY_SCOPE_AGENT); }
DI unsigned xb_add(unsigned* p, unsigned v) { return __hip_atomic_fetch_add(p, v, __ATOMIC_RELAXED, __HIP_MEMORY_SCOPE_AGENT); }
DI unsigned xb_xcc_id() { return (unsigned)__builtin_amdgcn_s_getreg((3 << 11) | 20) & 0xFu; }
#define XB_SPIN(cond, bar) do { unsigned _sp = 0; while (cond) { __builtin_amdgcn_s_sleep(1); \
    if ((++_sp & 255u) == 0u) { if (xb_ld(&(bar)[XB_TMO])) break; if (_sp > XB_SPIN_CAP) { atomicAdd(&(bar)[XB_TMO], 1u); break; } } } } while (0)
struct XcdBarrier { unsigned* bar; unsigned x; volatile LAS unsigned* st; };
DI XcdBarrier xcd_barrier_post(unsigned* bar, volatile LAS unsigned* st) {
  XcdBarrier b; b.bar = bar; b.x = xb_xcc_id(); b.st = st;
  if (threadIdx.x == 0) (void)xb_add(&bar[XB_XCNT(b.x)], 1u);
  return b;
}
DI void xcd_barrier_complete(unsigned* bar, unsigned x, unsigned& nloc, unsigned& nx) {
  const unsigned G = gridDim.x * gridDim.y * gridDim.z;
  unsigned sum, cnt, mine, sp = 0u;
  for (;;) {
    sum = 0u; cnt = 0u; mine = 0u;
#pragma unroll
    for (unsigned j = 0; j < 16; ++j) { const unsigned c = xb_ld(&bar[XB_XCNT(j)]); sum += c; cnt += (c > 0u) ? 1u : 0u; mine = (j == x) ? c : mine; }
    if (sum == G) break;
    __builtin_amdgcn_s_sleep(1);
    if ((++sp & 255u) == 0u) { if (xb_ld(&bar[XB_TMO])) break; if (sp > XB_SPIN_CAP) { atomicAdd(&bar[XB_TMO], 1u); break; } }
  }
  nloc = mine > 0u ? mine : 1u; nx = cnt > 0u ? cnt : 1u;
}
DI void xcd_barrier(const XcdBarrier& b) {
  asm volatile("s_waitcnt vmcnt(0)" ::: "memory");
  __syncthreads();
  if (threadIdx.x == 0) {
    unsigned* bar = b.bar;
    __builtin_amdgcn_s_waitcnt(0);
    unsigned nloc = b.st[0], nx = b.st[1];
    if (nloc == 0u) { xcd_barrier_complete(bar, b.x, nloc, nx); b.st[0] = nloc; b.st[1] = nx; }
    const unsigned old = xb_add(&bar[XB_XSUB(b.x)], 1u);
    const unsigned gen = old / nloc;
    if (old + 1u == (gen + 1u) * nloc) {
      __builtin_amdgcn_fence(__ATOMIC_RELEASE, "agent");
      asm volatile("s_waitcnt vmcnt(0)" ::: "memory");
      const unsigned og = xb_add(&bar[XB_TOP], 1u);
      const unsigned tg = og / nx;
      if (og + 1u == (tg + 1u) * nx) xb_add(&bar[XB_TOPGEN], 1u);
      else XB_SPIN(xb_ld(&bar[XB_TOPGEN]) == tg, bar);
      __builtin_amdgcn_fence(__ATOMIC_ACQUIRE, "agent");
      xb_add(&bar[XB_XGEN(b.x)], 1u);
      asm volatile("s_waitcnt vmcnt(0)" ::: "memory");
    } else {
      XB_SPIN(xb_ld(&bar[XB_XGEN(b.x)]) == gen, bar);
      __builtin_amdgcn_fence(__ATOMIC_ACQUIRE, "agent");
      asm volatile("s_waitcnt vmcnt(0)" ::: "memory");
    }
  }
  __syncthreads();
}

constexpr int N_PHASES = 7;
__host__ __device__ constexpr int phase_items(int ph) {
  return ph == 0 ? 2064 + 1760 : ph == 1 ? 5031 : ph == 2 ? 1024 : ph == 3 ? 512 : ph == 4 ? 1024 : ph == 5 ? 1024
         : ph == 6 ? 1024 : 4128;
}

#if MK_MULTI
#define GRID_SYNC(PH)
#else
#define GRID_SYNC(PH) if (PH < p.ph_hi) xcd_barrier(xb);
#endif
#define ITEMS(LO, HI, SHIFT, BODY) \
  for (int item = (LO) + (int)((blockIdx.x + (SHIFT)) % gridDim.x); item < (HI); item += gridDim.x) { BODY; }
#ifndef PROBE_REP
#define PROBE_REP(X)
#endif

__global__ void __launch_bounds__(256, 2) mega(Params p) {
  __shared__ __attribute__((aligned(16))) char smem[65536 + 1024];
#if !MK_MULTI
  __shared__ uint4 xb_words;
  if (threadIdx.x == 0) xb_words = make_uint4(0u, 0u, 0u, 0u);
  __syncthreads();
  XcdBarrier xb = xcd_barrier_post((unsigned*)(p.ws + OFF_BAR), (volatile LAS unsigned*)&xb_words);
  if (p.ph_lo > p.ph_hi) cg::this_grid().sync();
#endif
  if (p.ph_lo <= 0 && 0 <= p.ph_hi) {
    ITEMS(0, 2064 + 1760, 0, p0_item(p, item, smem))
    GRID_SYNC(0)
  }
  if (p.ph_lo <= 1 && 1 <= p.ph_hi) {
    ITEMS(0, 5031, 0, p1_tile(p, item, smem))
    GRID_SYNC(1)
  }
  if (p.ph_lo <= 2 && 2 <= p.ph_hi) {
    {
      GlaPre R;
      int item = blockIdx.x;
      if (item < 1024) p2a_gla_load(p, item, R);
      for (; item < 1024; item += gridDim.x) p2a_gla(p, item, item + (int)gridDim.x, smem, R);
    }
    ITEMS(0, 1024, 0, p2a_ssd(p, item, smem))
    ITEMS(0, 256, 0, p2a_gla_sample2(p, item, smem))
    ITEMS(0, 256, 256, p2a_ssd_sample(p, item, smem))
    GRID_SYNC(2)
  }
  if (p.ph_lo <= 3 && 3 <= p.ph_hi) {
    ITEMS(0, 512, 0, p2b_item(p, item))
    GRID_SYNC(3)
  }
  if (p.ph_lo <= 4 && 4 <= p.ph_hi) {
    ITEMS(0, 128, 0, p3_sample(p, item, smem))
    {
      GlcPre R;
      int item = blockIdx.x;
      if (item < 1024) p2c_gla_load(p, item, R);
      for (; item < 1024; item += gridDim.x) p2c_gla(p, item, item + (int)gridDim.x, smem, R);
    }
    ITEMS(0, 512, 0, p2c_ssd(p, item, smem))
    GRID_SYNC(4)
  }
  if (p.ph_lo <= 5 && 5 <= p.ph_hi) {
    ITEMS(0, 128, 0, p4_sample(p, item, smem))
    ITEMS(0, 1024, 0, p3_tile(p, item, smem))
    GRID_SYNC(5)
  }
  if (p.ph_lo <= 6 && 6 <= p.ph_hi) {
    ITEMS(0, 32, 0, p5_item(p, item, p.out + O_YS))
    ITEMS(0, 1024, 0, p4_tile(p, item, smem))
  }
#ifdef PROBE_P5
  if (p.ph_lo == 8) { ITEMS(0, 4128, 0, p5_item(p, item, (float*)(p.ws + OFF_PROJ))) }
#endif
}

extern "C" void kernel_launch(void* const* d_in, const int* in_sizes, int n_in, void* d_out, int out_size, void* d_ws, size_t ws_size,
                              hipStream_t stream) {
  (void)in_sizes; (void)n_in; (void)out_size;
  if (ws_size < WS_NEED) fprintf(stderr, "kernel_launch: workspace too small (%zu < %zu)\n", ws_size, WS_NEED);
  Params p{};
  const float** f = (const float**)&p;
  for (int i = 0; i < 20; ++i) f[i] = (const float*)d_in[i];
  p.out = (float*)d_out;
  p.ws = (char*)d_ws;
  hipMemsetAsync((char*)d_ws + OFF_BAR, 0, XCD_BAR_WORDS * 4 + 1024, stream);
#if MK_MULTI
  for (int ph = 0; ph < N_PHASES; ++ph) {
    p.ph_lo = ph; p.ph_hi = ph;
    hipLaunchKernelGGL(mega, dim3(phase_items(ph)), dim3(256), 0, stream, p);
#ifdef PROBE_P5
    if (ph == 7) { p.ph_lo = 8; p.ph_hi = 8; for (int rep = 0; rep < 2; ++rep) hipLaunchKernelGGL(mega, dim3(4128), dim3(256), 0, stream, p); }
#endif
#ifdef PROBE_REP_PH
    if (ph == PROBE_REP_PH) for (int rep = 0; rep < 2; ++rep) hipLaunchKernelGGL(mega, dim3(phase_items(ph)), dim3(256), 0, stream, p);
#endif
  }
#else
  static int grid_blocks = 0;
  if (!grid_blocks) {
    int dev = 0, cus = 0, per_cu = 0;
    hipGetDevice(&dev);
    hipDeviceGetAttribute(&cus, hipDeviceAttributeMultiprocessorCount, dev);
    hipOccupancyMaxActiveBlocksPerMultiprocessor(&per_cu, mega, 256, 0);
    if (per_cu < 1) per_cu = 1;
    if (per_cu > 2) per_cu = 2;
    grid_blocks = (cus * per_cu) & ~63;
  }
  p.ph_lo = 0; p.ph_hi = N_PHASES - 1;
  void* args[] = {&p};
  hipError_t e = hipLaunchCooperativeKernel((void*)mega, dim3(grid_blocks), dim3(256), args, 0, stream);
  if (e != hipSuccess) fprintf(stderr, "cooperative launch failed: %s (grid %d)\n", hipGetErrorString(e), grid_blocks);
#endif
}
```

```cpp
#include <hip/hip_runtime.h>
#include <hip/hip_cooperative_groups.h>
#include <cstdio>
namespace cg = cooperative_groups;

#ifndef MK_MULTI
#define MK_MULTI 0
#endif

typedef unsigned short u16;
typedef __attribute__((ext_vector_type(8))) short bf16x8;
typedef __attribute__((ext_vector_type(16))) float f32x16;
typedef __attribute__((ext_vector_type(4))) unsigned u32x4;
#define DI __device__ __forceinline__
#define MFMA(a, b, c) __builtin_amdgcn_mfma_f32_32x32x16_bf16((a), (b), (c), 0, 0, 0)

constexpr int T_ALL = 16512, T_P = 16384, NP = 4992;
constexpr int CQ = 0, CK = 256, CV = 512, CG = 1024, CZ = 1536, CX = 2048, CGA = 2816, CGB = 3840, CAL = 4864, CDT = 4880;
constexpr size_t OFF_PROJ = 0;
constexpr size_t OFF_WIN = 164855808;
constexpr size_t OFF_WG = 175079424;
constexpr size_t OFF_WS = 176128000;
constexpr size_t OFF_WO = 177176576;
constexpr size_t OFF_X1 = 179273728;
constexpr size_t OFF_X2 = 213090304;
constexpr size_t OFF_DT = 246906880;
constexpr size_t OFF_CUM = 247431168;
constexpr size_t OFF_GG = 247955456;
constexpr size_t OFF_GS = 248217600;
constexpr size_t OFF_BAR = 248225792;
constexpr size_t OFF_CNT = OFF_BAR + 13824;
constexpr size_t OFF_RPART = OFF_CNT + 1024;
constexpr size_t WS_NEED = OFF_RPART + 524288;
constexpr size_t O_YS = 16777216, O_GLAP = 16908288, O_SSMP = 17170432, O_CONVP = 17432576, O_GLAS = 17451008, O_SSMS = 21645312, O_CONVS = 25839616;
constexpr size_t OUTB_HN = 0, OUTB_XBCC = 33816576;
constexpr size_t OUTB_QK = 0, OUTB_VT = 16777216;

struct Params {
  const float *x_p, *x_s, *st_gla, *st_ssm, *st_conv, *norm_g, *w_in, *w_a2, *b_a2, *gla_ng, *conv_w, *conv_b, *dt_bias, *a_log,
      *d_skip, *ssd_ng, *w_brg, *w_brs, *w_out, *fin_g;
  float* out;
  char* ws;
  int ph_lo, ph_hi;
};

DI u16 f2bf(float x) { unsigned u = __float_as_uint(x); u += 0x7fffu + ((u >> 16) & 1u); return (u16)(u >> 16); }
DI float bf2f(u16 v) { return __uint_as_float(((unsigned)v) << 16); }
DI unsigned pack2(float a, float b) { return (unsigned)f2bf(a) | ((unsigned)f2bf(b) << 16); }
DI float bflo(unsigned u) { return __uint_as_float(u << 16); }
DI float bfhi(unsigned u) { return __uint_as_float(u & 0xffff0000u); }
DI int crow(int r, int h) { return (r & 3) + 8 * (r >> 2) + 4 * h; }
DI int img_off(int row, int k) { return row * 128 + ((((k >> 3) ^ (row >> 1)) & 7) << 4) + ((k & 7) << 1); }
DI int chunk_off(int row, int chunk) { return row * 128 + (((chunk ^ (row >> 1)) & 7) << 4); }
DI bf16x8 frag(const char* img, int row0, int ks, int lane) {
  int row = row0 + (lane & 31);
  return *(const bf16x8*)(img + chunk_off(row, ks * 2 + (lane >> 5)));
}
DI void mma64(f32x16& acc, const char* ia, int ra, const char* ib, int rb, int lane) {
#pragma unroll
  for (int ks = 0; ks < 4; ++ks) acc = MFMA(frag(ia, ra, ks, lane), frag(ib, rb, ks, lane), acc);
}
DI float sigm(float x) { return __builtin_amdgcn_rcpf(1.f + __expf(-x)); }
DI float silu(float x) { return x * __builtin_amdgcn_rcpf(1.f + __expf(-x)); }
DI float softplus(float x) { return fmaxf(x, 0.f) + __logf(1.f + __expf(-fabsf(x))); }
DI float logsig(float x) { return fminf(x, 0.f) - __logf(1.f + __expf(-fabsf(x))); }
DI float red32(float v) {
#pragma unroll
  for (int o = 16; o > 0; o >>= 1) v += __shfl_xor(v, o);
  return v;
}
DI float red64(float v) {
#pragma unroll
  for (int o = 32; o > 0; o >>= 1) v += __shfl_xor(v, o);
  return v;
}
DI f32x16 zero16() { f32x16 z; for (int i = 0; i < 16; ++i) z[i] = 0.f; return z; }

DI void transpose_tile(const float* __restrict__ src, int src_ld, int K, u16* __restrict__ dst, int n0, int k0, int mapcols, char* smem) {
  float* tile = (float*)smem;
  const int t = threadIdx.x, lane = t & 63, w = t >> 6;
  int n = n0 + lane, col;
  if (mapcols) {
    if (n < 1536) col = n; else if (n < 2816) col = n + 16; else if (n < 4864) col = n + 24;
    else if (n < 4880) col = 1536 + (n - 4864); else if (n < 4888) col = 2832 + (n - 4880); else col = -1;
  } else col = n;
#pragma unroll
  for (int r = 0; r < 16; ++r) {
    int kk = r * 4 + w;
    tile[kk * 65 + lane] = col >= 0 ? src[(size_t)(k0 + kk) * src_ld + col] : 0.f;
  }
  __syncthreads();
  {
    int nn = t >> 2, kq = t & 3;
    unsigned pk[8];
#pragma unroll
    for (int i = 0; i < 8; ++i) pk[i] = pack2(tile[(kq * 16 + 2 * i) * 65 + nn], tile[(kq * 16 + 2 * i + 1) * 65 + nn]);
    u32x4* d = (u32x4*)(dst + (size_t)(n0 + nn) * K + k0 + kq * 16);
    u32x4 a, b;
    a[0] = pk[0]; a[1] = pk[1]; a[2] = pk[2]; a[3] = pk[3]; b[0] = pk[4]; b[1] = pk[5]; b[2] = pk[6]; b[3] = pk[7];
    d[0] = a; d[1] = b;
  }
  __syncthreads();
}

DI void p0_item(const Params& p, int item, char* smem) {
  const int t = threadIdx.x, lane = t & 63, w = t >> 6;
  if (item < 2064) {
    const int row0 = item * 8 + w * 2;
    float4 v[2][4];
    float ss[2] = {0.f, 0.f};
#pragma unroll
    for (int rr = 0; rr < 2; ++rr) {
      const int row = row0 + rr;
      const float* xr = row < T_P ? p.x_p + (size_t)row * 1024 : p.x_s + (size_t)(row - T_P) * 1024;
#pragma unroll
      for (int i = 0; i < 4; ++i) v[rr][i] = ((const float4*)xr)[lane + 64 * i];
    }
#pragma unroll
    for (int rr = 0; rr < 2; ++rr) {
#pragma unroll
      for (int i = 0; i < 4; ++i) ss[rr] += v[rr][i].x * v[rr][i].x + v[rr][i].y * v[rr][i].y + v[rr][i].z * v[rr][i].z + v[rr][i].w * v[rr][i].w;
      ss[rr] = red64(ss[rr]);
    }
#pragma unroll
    for (int rr = 0; rr < 2; ++rr) {
      const float rs = rsqrtf(ss[rr] * (1.f / 1024.f) + 1e-6f);
      u16* hn = (u16*)((char*)p.out + OUTB_HN) + (size_t)(row0 + rr) * 1024;
#pragma unroll
      for (int i = 0; i < 4; ++i) {
        float4 g = ((const float4*)p.norm_g)[lane + 64 * i];
        uint2 o;
        o.x = pack2(v[rr][i].x * rs * g.x, v[rr][i].y * rs * g.y);
        o.y = pack2(v[rr][i].z * rs * g.z, v[rr][i].w * rs * g.w);
        *(uint2*)(hn + (lane + 64 * i) * 4) = o;
      }
    }
  } else {
    int idx = item - 2064;
    if (idx < 1248) transpose_tile(p.w_in, 4888, 1024, (u16*)(p.ws + OFF_WIN), (idx >> 4) * 64, (idx & 15) * 64, 1, smem);
    else if (idx < 1376) { idx -= 1248; transpose_tile(p.w_brg, 1024, 1024, (u16*)(p.ws + OFF_WG), (idx >> 3) * 64, (idx & 7) * 64, 0, smem); }
    else if (idx < 1504) { idx -= 1376; transpose_tile(p.w_brs, 1024, 1024, (u16*)(p.ws + OFF_WG) + 512, (idx >> 3) * 64, (idx & 7) * 64, 0, smem); }
    else { idx -= 1504; transpose_tile(p.w_out, 1024, 1024, (u16*)(p.ws + OFF_WO), (idx >> 4) * 64, (idx & 15) * 64, 0, smem); }
  }
}

#define GLDS(gp, lp) __builtin_amdgcn_global_load_lds((const unsigned*)(gp), (__attribute__((address_space(3))) unsigned*)(lp), 16, 0, 0)
DI void gemm_range(const u16* __restrict__ A, int lda, const u16* __restrict__ B, int ldb, int kt0, int kt1, int nk, bool prologue, char* smem, f32x16 (&acc)[2][2]) {
  const int t = threadIdx.x, lane = t & 63, w = t >> 6, wm = w >> 1, wn = w & 1;
  const int lr = t >> 3, lc = (t ^ (t >> 4)) & 7;
  const u16* ap = A + (size_t)lr * lda + lc * 8;
  const u16* bp = B + (size_t)lr * ldb + lc * 8;
  char* sdst = smem + t * 16;
  const int l = lane & 31, hh = lane >> 5, sw = (l >> 1) & 7;
  const unsigned lbase = (unsigned)(size_t)smem;
  const unsigned rA = lbase + (wm * 64 + l) * 128, rB = lbase + 16384 + (wn * 64 + l) * 128;
  const unsigned x0 = (((0 + hh) ^ sw) & 7) << 4, x1 = (((2 + hh) ^ sw) & 7) << 4, x2 = (((4 + hh) ^ sw) & 7) << 4, x3 = (((6 + hh) ^ sw) & 7) << 4;
  if (prologue) {
#pragma unroll
    for (int i = 0; i < 4; ++i) { GLDS(ap + (size_t)(32 * i) * lda, sdst + i * 4096); GLDS(bp + (size_t)(32 * i) * ldb, sdst + 16384 + i * 4096); }
    asm volatile("s_waitcnt vmcnt(0)" ::: "memory");
    __builtin_amdgcn_s_barrier();
    asm volatile("" ::: "memory");
  }
#pragma unroll 1
  for (int kt = kt0; kt < kt1; ++kt) {
    if (kt + 1 < nk) {
      char* d = sdst + ((kt + 1) & 1) * 32768;
      const u16* a2 = ap + (kt + 1) * 64;
      const u16* b2 = bp + (kt + 1) * 64;
#pragma unroll
      for (int i = 0; i < 4; ++i) { GLDS(a2 + (size_t)(32 * i) * lda, d + i * 4096); GLDS(b2 + (size_t)(32 * i) * ldb, d + 16384 + i * 4096); }
    }
    const unsigned so = (kt & 1) * 32768;
#define RD4(a0_, a1_, b0_, b1_, x_) asm volatile("ds_read_b128 %0, %4\n\tds_read_b128 %1, %4 offset:4096\n\tds_read_b128 %2, %5\n\tds_read_b128 %3, %5 offset:4096" \
        : "=&v"(a0_), "=&v"(a1_), "=&v"(b0_), "=&v"(b1_) : "v"(rA + so + (x_)), "v"(rB + so + (x_)) : "memory")
#define WT4(n_, a0_, a1_, b0_, b1_) asm volatile("s_waitcnt lgkmcnt(" #n_ ")" : "+v"(a0_), "+v"(a1_), "+v"(b0_), "+v"(b1_))
#define MM4(a0_, a1_, b0_, b1_) do { acc[0][0] = MFMA(a0_, b0_, acc[0][0]); acc[0][1] = MFMA(a0_, b1_, acc[0][1]); \
        acc[1][0] = MFMA(a1_, b0_, acc[1][0]); acc[1][1] = MFMA(a1_, b1_, acc[1][1]); } while (0)
    bf16x8 a00, a01, b00, b01, a10, a11, b10, b11, a20, a21, b20, b21, a30, a31, b30, b31;
    RD4(a00, a01, b00, b01, x0);
    RD4(a10, a11, b10, b11, x1);
    WT4(4, a00, a01, b00, b01);
    MM4(a00, a01, b00, b01);
    RD4(a20, a21, b20, b21, x2);
    WT4(4, a10, a11, b10, b11);
    MM4(a10, a11, b10, b11);
    RD4(a30, a31, b30, b31, x3);
    WT4(4, a20, a21, b20, b21);
    MM4(a20, a21, b20, b21);
    WT4(0, a30, a31, b30, b31);
    MM4(a30, a31, b30, b31);
#undef RD4
#undef WT4
#undef MM4
    asm volatile("s_waitcnt vmcnt(0)" ::: "memory");
    __builtin_amdgcn_s_barrier();
    asm volatile("" ::: "memory");
  }
}

DI void gemm_core(const u16* __restrict__ A, int lda, const u16* __restrict__ B, int ldb, int nk, char* smem, f32x16 (&acc)[2][2]) {
  gemm_range(A, lda, B, ldb, 0, nk, nk, true, smem, acc);
}

DI void acc_to_lds(const f32x16 (&acc)[2][2], float* T) {
  const int lane = threadIdx.x & 63, w = threadIdx.x >> 6, wm = w >> 1, wn = w & 1, h = lane >> 5;
  float* base = T + (wm * 64 + 4 * h) * 128 + wn * 64 + (lane & 31);
#pragma unroll
  for (int i = 0; i < 2; ++i)
#pragma unroll
    for (int j = 0; j < 2; ++j)
#pragma unroll
      for (int r2 = 0; r2 < 16; ++r2) base[(i * 32 + (r2 & 3) + 8 * (r2 >> 2)) * 128 + j * 32] = acc[i][j][r2];
}
#define EPI_ROW(it2) (w * 32 + (it2) * 4 + (lane >> 4))
#define EPI_COL ((lane & 15) * 8)

DI void p1_tile(const Params& p, int tile, char* smem) {
  int mblk, nblk;
  if (tile < 4992) {
    const int b = tile & 511, k = tile >> 9, xcd = b & 7, q = k * 64 + (b >> 3);
    const int half = q >= 312 ? 1 : 0, r = q - half * 312;
    int nstep, rr;
    if (r < 256) { nstep = r >> 6; rr = r & 63; } else { nstep = 4; rr = r - 256; }
    mblk = xcd * 16 + half * 8 + (rr & 7);
    nblk = nstep * 8 + (rr >> 3);
  } else { mblk = 128; nblk = tile - 4992; }
  const int m0 = mblk * 128, n0 = nblk * 128;
  const u16* hn = (const u16*)((const char*)p.out + OUTB_HN);
  f32x16 acc[2][2];
  for (int i = 0; i < 2; ++i) for (int j = 0; j < 2; ++j) acc[i][j] = zero16();
  gemm_core(hn + (size_t)m0 * 1024, 1024, (const u16*)(p.ws + OFF_WIN) + (size_t)n0 * 1024, 1024, 16, smem, acc);
  const int lane = threadIdx.x & 63, w = threadIdx.x >> 6;
  float* T = (float*)smem;
  acc_to_lds(acc, T);
  __syncthreads();
  u16* proj = (u16*)(p.ws + OFF_PROJ) + (size_t)m0 * NP + n0 + EPI_COL;
#pragma unroll
  for (int it2 = 0; it2 < 8; ++it2) {
    int row = EPI_ROW(it2);
    float4 v0 = *(const float4*)(T + row * 128 + EPI_COL), v1 = *(const float4*)(T + row * 128 + EPI_COL + 4);
    u32x4 o; o[0] = pack2(v0.x, v0.y); o[1] = pack2(v0.z, v0.w); o[2] = pack2(v1.x, v1.y); o[3] = pack2(v1.z, v1.w);
    *(u32x4*)(proj + (size_t)row * NP) = o;
  }
  __syncthreads();
}

DI void p3_tile(const Params& p, int tile, char* smem) {
  const int tb = tile & 511, tk = tile >> 9, tj = tb >> 3;
  int m0 = (tk * 64 + (tb & 7) * 8 + (tj >> 3)) * 128, n0 = (tj & 7) * 128;
  const u16* U = (const u16*)(p.ws + OFF_X1) + (size_t)m0 * 1024;
  const u16* Wm = (const u16*)(p.ws + OFF_WG) + (size_t)n0 * 1024;
  const int lane = threadIdx.x & 63, w = threadIdx.x >> 6;
  const u16* gate = (const u16*)(p.ws + OFF_PROJ) + (size_t)m0 * NP + n0 + EPI_COL;
  u16* mg = (u16*)(p.ws + OFF_X2) + (size_t)m0 * 1024 + n0 + EPI_COL;
  float* T = (float*)smem;
  f32x16 acc[2][2], acc2[2][2];
  for (int i = 0; i < 2; ++i) for (int j = 0; j < 2; ++j) { acc[i][j] = zero16(); acc2[i][j] = zero16(); }
  gemm_range(U, 1024, Wm, 1024, 0, 8, 16, true, smem, acc);
  gemm_range(U, 1024, Wm, 1024, 8, 16, 16, false, smem, acc2);
  acc_to_lds(acc, T);
  __syncthreads();
  u32x4 gbv[8];
#pragma unroll
  for (int it2 = 0; it2 < 8; ++it2) gbv[it2] = *(const u32x4*)(gate + (size_t)EPI_ROW(it2) * NP + CGB);
  u32x4 m1[8];
#pragma unroll
  for (int it2 = 0; it2 < 8; ++it2) {
    int row = EPI_ROW(it2);
    u32x4 ga = *(const u32x4*)(gate + (size_t)row * NP + CGA);
    float4 v0 = *(const float4*)(T + row * 128 + EPI_COL), v1 = *(const float4*)(T + row * 128 + EPI_COL + 4);
    m1[it2][0] = pack2(v0.x * sigm(bflo(ga[0])), v0.y * sigm(bfhi(ga[0])));
    m1[it2][1] = pack2(v0.z * sigm(bflo(ga[1])), v0.w * sigm(bfhi(ga[1])));
    m1[it2][2] = pack2(v1.x * sigm(bflo(ga[2])), v1.y * sigm(bfhi(ga[2])));
    m1[it2][3] = pack2(v1.z * sigm(bflo(ga[3])), v1.w * sigm(bfhi(ga[3])));
  }
  __syncthreads();
  acc_to_lds(acc2, T);
  __syncthreads();
#pragma unroll
  for (int it2 = 0; it2 < 8; ++it2) {
    int row = EPI_ROW(it2);
    const u32x4 gb = gbv[it2];
    float4 v0 = *(const float4*)(T + row * 128 + EPI_COL), v1 = *(const float4*)(T + row * 128 + EPI_COL + 4);
    u32x4 o;
    o[0] = pack2(bflo(m1[it2][0]) + v0.x * sigm(bflo(gb[0])), bfhi(m1[it2][0]) + v0.y * sigm(bfhi(gb[0])));
    o[1] = pack2(bflo(m1[it2][1]) + v0.z * sigm(bflo(gb[1])), bfhi(m1[it2][1]) + v0.w * sigm(bfhi(gb[1])));
    o[2] = pack2(bflo(m1[it2][2]) + v1.x * sigm(bflo(gb[2])), bfhi(m1[it2][2]) + v1.y * sigm(bfhi(gb[2])));
    o[3] = pack2(bflo(m1[it2][3]) + v1.z * sigm(bflo(gb[3])), bfhi(m1[it2][3]) + v1.w * sigm(bfhi(gb[3])));
    *(u32x4*)(mg + (size_t)row * 1024) = o;
  }
  __syncthreads();
}

DI void p4_tile(const Params& p, int tile, char* smem) {
  const int tb = tile & 511, tk = tile >> 9, tj = tb >> 3;
  const int mb = tk * 64 + (tb & 7) * 8 + (tj >> 3), nb = tj & 7, m0 = mb * 128, n0 = nb * 128;
  const u16* mg = (const u16*)(p.ws + OFF_X2);
  const int lane = threadIdx.x & 63, w = threadIdx.x >> 6;
  float* T = (float*)smem;
  f32x16 acc[2][2];
  for (int i = 0; i < 2; ++i) for (int j = 0; j < 2; ++j) acc[i][j] = zero16();
  gemm_core(mg + (size_t)m0 * 1024, 1024, (const u16*)(p.ws + OFF_WO) + (size_t)n0 * 1024, 1024, 16, smem, acc);
  float4 xa[8], xb[8];
#pragma unroll
  for (int it2 = 0; it2 < 8; ++it2) {
    const float* xr = p.x_p + (size_t)(m0 + EPI_ROW(it2)) * 1024 + n0 + EPI_COL;
    xa[it2] = *(const float4*)xr; xb[it2] = *(const float4*)(xr + 4);
  }
  acc_to_lds(acc, T);
  __syncthreads();
  float* rpart = (float*)(p.ws + OFF_RPART);
  unsigned* cnt = (unsigned*)(p.ws + OFF_CNT);
#pragma unroll
  for (int it2 = 0; it2 < 8; ++it2) {
    const int lrow = EPI_ROW(it2);
    float* tp = T + lrow * 128 + EPI_COL;
    float4 v0 = *(const float4*)tp, v1 = *(const float4*)(tp + 4);
    const float4 x0 = xa[it2], x1 = xb[it2];
    v0.x += x0.x; v0.y += x0.y; v0.z += x0.z; v0.w += x0.w; v1.x += x1.x; v1.y += x1.y; v1.z += x1.z; v1.w += x1.w;
    *(float4*)tp = v0; *(float4*)(tp + 4) = v1;
    float ss = v0.x * v0.x + v0.y * v0.y + v0.z * v0.z + v0.w * v0.w + v1.x * v1.x + v1.y * v1.y + v1.z * v1.z + v1.w * v1.w;
    ss += __shfl_xor(ss, 1); ss += __shfl_xor(ss, 2); ss += __shfl_xor(ss, 4); ss += __shfl_xor(ss, 8);
    if ((lane & 15) == 0) __hip_atomic_store(rpart + (size_t)(mb * 8 + nb) * 128 + lrow, ss, __ATOMIC_RELAXED, __HIP_MEMORY_SCOPE_AGENT);
  }
  asm volatile("s_waitcnt vmcnt(0)" ::: "memory");
  __syncthreads();
  if (threadIdx.x == 0) {
    __hip_atomic_fetch_add(cnt + mb, 1u, __ATOMIC_RELAXED, __HIP_MEMORY_SCOPE_AGENT);
    unsigned sp = 0;
    while (__hip_atomic_load(cnt + mb, __ATOMIC_RELAXED, __HIP_MEMORY_SCOPE_AGENT) < 8u) { __builtin_amdgcn_s_sleep(2); if (++sp > (1u << 22)) break; }
  }
  __syncthreads();
  const float4 g0 = *(const float4*)(p.fin_g + n0 + EPI_COL), g1 = *(const float4*)(p.fin_g + n0 + EPI_COL + 4);
#pragma unroll
  for (int it2 = 0; it2 < 8; ++it2) {
    const int lrow = EPI_ROW(it2);
    float tot = 0.f;
#pragma unroll
    for (int q = 0; q < 8; ++q) tot += __hip_atomic_load(rpart + (size_t)(mb * 8 + q) * 128 + lrow, __ATOMIC_RELAXED, __HIP_MEMORY_SCOPE_AGENT);
    const float rs = rsqrtf(tot * (1.f / 1024.f) + 1e-6f);
    const float* tp = T + lrow * 128 + EPI_COL;
    float4 v0 = *(const float4*)tp, v1 = *(const float4*)(tp + 4);
    v0.x *= rs * g0.x; v0.y *= rs * g0.y; v0.z *= rs * g0.z; v0.w *= rs * g0.w; v1.x *= rs * g1.x; v1.y *= rs * g1.y; v1.z *= rs * g1.z; v1.w *= rs * g1.w;
    float* op = p.out + (size_t)(m0 + lrow) * 1024 + n0 + EPI_COL;
    *(float4*)op = v0; *(float4*)(op + 4) = v1;
  }
  __syncthreads();
}

DI f32x16 wgemm32(const u16* __restrict__ A, int lda, const u16* __restrict__ B, int ldb, int k0, int k1, int lane) {
  const u16* ap = A + (size_t)(lane & 31) * lda + (lane >> 5) * 8;
  const u16* bp = B + (size_t)(lane & 31) * ldb + (lane >> 5) * 8;
  f32x16 acc = zero16();
#pragma unroll 8
  for (int k = k0; k < k1; k += 16) acc = MFMA(*(const bf16x8*)(ap + k), *(const bf16x8*)(bp + k), acc);
  return acc;
}
DI void red_put(const f32x16& acc, float* red, int w, int lane) {
#pragma unroll
  for (int r = 0; r < 16; ++r) red[(w * 16 + r) * 64 + lane] = acc[r];
}
DI float red_get(const float* red, int r, int lane) { return red[r * 64 + lane] + red[(16 + r) * 64 + lane] + red[(32 + r) * 64 + lane] + red[(48 + r) * 64 + lane]; }

DI void p3_sample(const Params& p, int item, char* smem) {
  const int mt = item >> 5, nt = item & 31, lane = threadIdx.x & 63, w = threadIdx.x >> 6, hh = lane >> 5;
  const u16* U = (const u16*)(p.ws + OFF_X1) + (size_t)(T_P + mt * 32) * 1024;
  float* red = (float*)smem;
  const u16* proj = (const u16*)(p.ws + OFF_PROJ);
  float gav[4], gbv[4];
#pragma unroll
  for (int q = 0; q < 4; ++q) {
    const int row = T_P + mt * 32 + crow(w * 4 + q, hh), col = nt * 32 + (lane & 31);
    gav[q] = bf2f(proj[(size_t)row * NP + CGA + col]); gbv[q] = bf2f(proj[(size_t)row * NP + CGB + col]);
  }
  f32x16 a1 = wgemm32(U, 1024, (const u16*)(p.ws + OFF_WG) + (size_t)nt * 32 * 1024, 1024, w * 128, w * 128 + 128, lane);
  f32x16 a2 = wgemm32(U + 512, 1024, (const u16*)(p.ws + OFF_WG) + (size_t)nt * 32 * 1024 + 512, 1024, w * 128, w * 128 + 128, lane);
  red_put(a1, red, w, lane);
  red_put(a2, red + 4096, w, lane);
  __syncthreads();
  u16* mg = (u16*)(p.ws + OFF_X2);
#pragma unroll
  for (int q = 0; q < 4; ++q) {
    const int r = w * 4 + q, row = T_P + mt * 32 + crow(r, hh), col = nt * 32 + (lane & 31);
    const float ga = gav[q], gb = gbv[q];
    mg[(size_t)row * 1024 + col] = f2bf(red_get(red, r, lane) * sigm(ga) + red_get(red + 4096, r, lane) * sigm(gb));
  }
  __syncthreads();
}

DI void p4_sample(const Params& p, int item, char* smem) {
  const int mt = item >> 5, nt = item & 31, lane = threadIdx.x & 63, w = threadIdx.x >> 6, hh = lane >> 5;
  const u16* mg = (const u16*)(p.ws + OFF_X2) + (size_t)(T_P + mt * 32) * 1024;
  float* red = (float*)smem;
  float xv[4];
#pragma unroll
  for (int q = 0; q < 4; ++q) xv[q] = p.x_s[(size_t)(mt * 32 + crow(w * 4 + q, hh)) * 1024 + nt * 32 + (lane & 31)];
  f32x16 a = wgemm32(mg, 1024, (const u16*)(p.ws + OFF_WO) + (size_t)nt * 32 * 1024, 1024, w * 256, w * 256 + 256, lane);
  red_put(a, red, w, lane);
  __syncthreads();
#pragma unroll
  for (int q = 0; q < 4; ++q) {
    const int r = w * 4 + q, srow = mt * 32 + crow(r, hh), col = nt * 32 + (lane & 31);
    p.out[O_YS + (size_t)srow * 1024 + col] = xv[q] + red_get(red, r, lane);
  }
  __syncthreads();
}

DI void p5_item(const Params& p, int item, float* basep) {
  const int lane = threadIdx.x & 63, w = threadIdx.x >> 6;
  int row = item * 4 + w;
  float4* o = (float4*)(basep + (size_t)row * 1024);
  float4 v[4];
  float ss = 0.f;
#pragma unroll
  for (int i = 0; i < 4; ++i) { v[i] = o[lane + 64 * i]; ss += v[i].x * v[i].x + v[i].y * v[i].y + v[i].z * v[i].z + v[i].w * v[i].w; }
  ss = red64(ss);
  float rs = rsqrtf(ss * (1.f / 1024.f) + 1e-6f);
#pragma unroll
  for (int i = 0; i < 4; ++i) {
    float4 g = ((const float4*)p.fin_g)[lane + 64 * i];
    float4 r; r.x = v[i].x * rs * g.x; r.y = v[i].y * rs * g.y; r.z = v[i].z * rs * g.z; r.w = v[i].w * rs * g.w;
    o[lane + 64 * i] = r;
  }
}

DI void g2img(const u16* __restrict__ src, size_t ld, char* img, int rows) {
  const int t = threadIdx.x, r = t >> 3, ch = t & 7;
  for (int r0 = 0; r0 < rows; r0 += 32) {
    int row = r0 + r;
    *(u32x4*)(img + chunk_off(row, ch)) = *(const u32x4*)(src + (size_t)row * ld + ch * 8);
  }
}
DI void img2g(const char* img, u16* __restrict__ dst, size_t ld, int rows) {
  const int t = threadIdx.x, r = t >> 3, ch = t & 7;
  for (int r0 = 0; r0 < rows; r0 += 32) {
    int row = r0 + r;
    *(u32x4*)(dst + (size_t)row * ld + ch * 8) = *(const u32x4*)(img + chunk_off(row, ch));
  }
}
DI unsigned lds16(const char* img, int row, int k) { return *(const u16*)(img + img_off(row, k)); }

typedef __attribute__((ext_vector_type(4))) short s16x4;
DI void tr_frags4(const char* img, int colbase, int lane, bf16x8 (&f)[4]) {
  const int h = lane >> 5, blk = (lane >> 4) & 1, q = (lane & 15) >> 2, pp = lane & 3;
  const int chunk = (colbase >> 3) + 2 * blk + (pp >> 1);
  const int r0 = 8 * h + q, r1 = r0 + 4;
  const unsigned a0 = (unsigned)(size_t)img + chunk_off(r0, chunk) + 8 * (pp & 1);
  const unsigned a1 = (unsigned)(size_t)img + chunk_off(r1, chunk) + 8 * (pp & 1);
  s16x4 l0, l1, l2, l3, u0, u1, u2, u3;
  asm volatile(
      "ds_read_b64_tr_b16 %0, %8\n\tds_read_b64_tr_b16 %1, %9\n\t"
      "ds_read_b64_tr_b16 %2, %8 offset:2048\n\tds_read_b64_tr_b16 %3, %9 offset:2048\n\t"
      "ds_read_b64_tr_b16 %4, %8 offset:4096\n\tds_read_b64_tr_b16 %5, %9 offset:4096\n\t"
      "ds_read_b64_tr_b16 %6, %8 offset:6144\n\tds_read_b64_tr_b16 %7, %9 offset:6144\n\t"
      "s_waitcnt lgkmcnt(0)"
      : "=&v"(l0), "=&v"(u0), "=&v"(l1), "=&v"(u1), "=&v"(l2), "=&v"(u2), "=&v"(l3), "=&v"(u3)
      : "v"(a0), "v"(a1)
      : "memory");
  f[0] = __builtin_shufflevector(l0, u0, 0, 1, 2, 3, 4, 5, 6, 7);
  f[1] = __builtin_shufflevector(l1, u1, 0, 1, 2, 3, 4, 5, 6, 7);
  f[2] = __builtin_shufflevector(l2, u2, 0, 1, 2, 3, 4, 5, 6, 7);
  f[3] = __builtin_shufflevector(l3, u3, 0, 1, 2, 3, 4, 5, 6, 7);
}

struct GlaPre { u32x4 q0, q1, k0, k1, v0, v1, v2, v3, al; };
DI void p2a_gla_load(const Params& p, int item, GlaPre& R) {
  const int h = item & 3, c = (item >> 2) & 31, b = item >> 7;
  const int t = threadIdx.x, pr = t >> 3, pch = t & 7;
  const u16* proj = (const u16*)(p.ws + OFF_PROJ) + (size_t)(b * 2048 + c * 64) * NP;
  const u16* r0 = proj + (size_t)pr * NP + pch * 8;
  const u16* r1 = r0 + (size_t)32 * NP;
  R.q0 = *(const u32x4*)(r0 + CQ + h * 64); R.q1 = *(const u32x4*)(r1 + CQ + h * 64);
  R.k0 = *(const u32x4*)(r0 + CK + h * 64); R.k1 = *(const u32x4*)(r1 + CK + h * 64);
  R.v0 = *(const u32x4*)(r0 + CV + h * 128); R.v1 = *(const u32x4*)(r1 + CV + h * 128);
  R.v2 = *(const u32x4*)(r0 + CV + h * 128 + 64); R.v3 = *(const u32x4*)(r1 + CV + h * 128 + 64);
  R.al = *(const u32x4*)(proj + (size_t)((t >> 1) & 63) * NP + CAL + (t & 1) * 8);
}

DI void p2a_gla(const Params& p, int item, int next_item, char* smem, GlaPre& R) {
  const int h = item & 3, c = (item >> 2) & 31, b = item >> 7;
  const int t = threadIdx.x, lane = t & 63, w = t >> 6, d = t & 63, tg = w;
  const int tok0 = b * 2048 + c * 64;
  const u16* proj = (const u16*)(p.ws + OFF_PROJ) + (size_t)tok0 * NP;
  u16* qk = (u16*)((char*)p.out + OUTB_QK) + (size_t)tok0 * 512;
  u16* vtg = (u16*)((char*)p.out + OUTB_VT) + (size_t)item * 8192;
  char* Qn = smem;
  char* Kn = smem + 8192;
  char* Vn = smem + 16384;
  char* VT = smem + 32768;
  char* KT = smem + 49152;
  char* al_s = smem + 57344;
  float* tot_s = (float*)(smem + 59392);
  {
    const int pr = t >> 3, pch = t & 7;
    *(u32x4*)(Qn + chunk_off(pr, pch)) = R.q0; *(u32x4*)(Qn + chunk_off(pr + 32, pch)) = R.q1;
    *(u32x4*)(Kn + chunk_off(pr, pch)) = R.k0; *(u32x4*)(Kn + chunk_off(pr + 32, pch)) = R.k1;
    *(u32x4*)(Vn + chunk_off(pr, pch)) = R.v0; *(u32x4*)(Vn + chunk_off(pr + 32, pch)) = R.v1;
    *(u32x4*)(Vn + 8192 + chunk_off(pr, pch)) = R.v2; *(u32x4*)(Vn + 8192 + chunk_off(pr + 32, pch)) = R.v3;
    if (t < 128) *(u32x4*)(al_s + (t >> 1) * 32 + (t & 1) * 16) = R.al;
    if (next_item < 1024) p2a_gla_load(p, next_item, R);
  }
  float wa[16];
#pragma unroll
  for (int r = 0; r < 16; ++r) wa[r] = p.w_a2[r * 256 + h * 64 + d];
  const float bias = p.b_a2[h * 64 + d];
  __syncthreads();
  float bl[16];
  float run = 0.f;
#pragma unroll
  for (int jj = 0; jj < 16; ++jj) {
    const char* al = al_s + (tg * 16 + jj) * 32;
    u32x4 a0 = *(const u32x4*)al, a1 = *(const u32x4*)(al + 16);
    float x = bias;
#pragma unroll
    for (int q = 0; q < 4; ++q) {
      x += bflo(a0[q]) * wa[2 * q] + bfhi(a0[q]) * wa[2 * q + 1];
      x += bflo(a1[q]) * wa[8 + 2 * q] + bfhi(a1[q]) * wa[8 + 2 * q + 1];
    }
    run += logsig(x) * (1.f / 16.f);
    bl[jj] = run;
  }
  tot_s[tg * 64 + d] = run;
  __syncthreads();
  float off = 0.f;
#pragma unroll
  for (int g = 0; g < 4; ++g) off += (g < tg) ? tot_s[g * 64 + d] : 0.f;
#pragma unroll
  for (int jj = 0; jj < 16; ++jj) {
    const int j = tg * 16 + jj;
    const float bb = bl[jj] + off;
    u16* qp = (u16*)(Qn + img_off(j, d));
    u16* kp = (u16*)(Kn + img_off(j, d));
    const float eb = __expf(bb);
    *qp = f2bf(bf2f(*qp) * 0.125f * eb);
    *kp = f2bf(bf2f(*kp) * __builtin_amdgcn_rcpf(eb));
  }
  __syncthreads();
  img2g(Qn, qk + h * 64, 512, 64);
  img2g(Kn, qk + 256 + h * 64, 512, 64);
  const int dcol = lane & 31, hh = lane >> 5;
  float* gdec = (float*)(p.ws + OFF_GG) + (size_t)((b * 32 + c) * 4 + h) * 64;
  bf16x8 vfr[4];
  tr_frags4(Vn + (w >> 1) * 8192, (w & 1) * 32, lane, vfr);
#pragma unroll
  for (int dt = 0; dt < 2; ++dt) {
    f32x16 acc = zero16();
    bf16x8 kfr[4];
    tr_frags4(Kn, dt * 32, lane, kfr);
#pragma unroll
    for (int ks = 0; ks < 4; ++ks) acc = MFMA(vfr[ks], kfr[ks], acc);
    int dd = dt * 32 + dcol;
    float gd = __expf(tot_s[dd] + tot_s[64 + dd] + tot_s[128 + dd] + tot_s[192 + dd]);
    if (w == 0 && hh == 0) gdec[dd] = gd;
#pragma unroll
    for (int r = 0; r < 16; ++r) *(u16*)(VT + img_off(w * 32 + crow(r, hh), dd)) = f2bf(acc[r] * gd);
  }
  __syncthreads();
  img2g(VT, (u16*)(p.ws + OFF_X1) + (size_t)((b * 32 + c) * 4 + h) * 8192, 64, 128);
  __syncthreads();
}

DI void p2a_ssd(const Params& p, int item, char* smem) {
  const int pair = item & 1, grp = (item >> 1) & 1, c = (item >> 2) & 31, b = item >> 7;
  const int t = threadIdx.x, lane = t & 63, w = t >> 6;
  const int tok0 = b * 2048 + c * 64;
  const u16* proj = (const u16*)(p.ws + OFF_PROJ) + (size_t)tok0 * NP;
  u16* xbcc = (u16*)((char*)p.out + OUTB_XBCC) + (size_t)tok0 * 768;
  char* Xn = smem;
  char* Bn = smem + 16384;
  char* XT = smem + 24576;
  char* BT = smem + 40960;
  float* sc_s = (float*)(smem + 49152);
  if (w < 2) {
    int hd = grp * 4 + pair * 2 + w, tok = tok0 + lane;
    float dt = softplus(bf2f(proj[(size_t)lane * NP + CDT + hd]) + p.dt_bias[hd]);
    float cum = -__expf(p.a_log[hd]) * dt;
#pragma unroll
    for (int o = 1; o < 64; o <<= 1) { float n = __shfl_up(cum, o); if (lane >= o) cum += n; }
    float clast = __shfl(cum, 63);
    ((float*)(p.ws + OFF_DT))[(size_t)tok * 8 + hd] = dt;
    ((float*)(p.ws + OFF_CUM))[(size_t)tok * 8 + hd] = cum;
    sc_s[w * 64 + lane] = dt * __expf(clast - cum);
    if (lane == 63) ((float*)(p.ws + OFF_GS))[(b * 32 + c) * 8 + hd] = __expf(clast);
  }
  {
    const int o = t & 31;
    const int ch = o < 16 ? grp * 256 + pair * 128 + o * 8 : (o < 24 ? 512 + grp * 64 + (o - 16) * 8 : 640 + grp * 64 + (o - 24) * 8);
    float cw[4][8], cb[8];
#pragma unroll
    for (int k = 0; k < 4; ++k) {
      float4 a = *(const float4*)(p.conv_w + k * 768 + ch), bb = *(const float4*)(p.conv_w + k * 768 + ch + 4);
      cw[k][0] = a.x; cw[k][1] = a.y; cw[k][2] = a.z; cw[k][3] = a.w; cw[k][4] = bb.x; cw[k][5] = bb.y; cw[k][6] = bb.z; cw[k][7] = bb.w;
    }
    {
      float4 a = *(const float4*)(p.conv_b + ch), bb = *(const float4*)(p.conv_b + ch + 4);
      cb[0] = a.x; cb[1] = a.y; cb[2] = a.z; cb[3] = a.w; cb[4] = bb.x; cb[5] = bb.y; cb[6] = bb.z; cb[7] = bb.w;
    }
    const bool store_g = (o < 16) || (o < 24 ? pair == 0 : pair == 1);
    const int j0 = (t >> 5) * 8;
    u32x4 xr[11];
#pragma unroll
    for (int r = 0; r < 11; ++r) {
      const int jr = j0 - 3 + r;
      if (jr >= 0 || c > 0) xr[r] = *(const u32x4*)(proj + (ptrdiff_t)jr * NP + CX + ch);
      else { xr[r][0] = 0u; xr[r][1] = 0u; xr[r][2] = 0u; xr[r][3] = 0u; }
    }
#pragma unroll
    for (int i = 0; i < 8; ++i) {
      const int j = j0 + i;
      float s[8];
#pragma unroll
      for (int q = 0; q < 8; ++q) s[q] = cb[q];
#pragma unroll
      for (int k = 0; k < 4; ++k) {
#pragma unroll
        for (int q = 0; q < 4; ++q) { s[2 * q] += bflo(xr[i + k][q]) * cw[k][2 * q]; s[2 * q + 1] += bfhi(xr[i + k][q]) * cw[k][2 * q + 1]; }
      }
      u32x4 ov;
#pragma unroll
      for (int q = 0; q < 4; ++q) ov[q] = pack2(silu(s[2 * q]), silu(s[2 * q + 1]));
      if (store_g) *(u32x4*)(xbcc + (size_t)j * 768 + ch) = ov;
      if (o < 16) *(u32x4*)(Xn + (o >> 3) * 8192 + chunk_off(j, o & 7)) = ov;
      else if (o < 24) *(u32x4*)(Bn + chunk_off(j, o - 16)) = ov;
    }
  }
  __syncthreads();
  {
    const int row = t & 127, half = t >> 7, hl = row >> 6, pp = row & 63;
    const char* ximg = Xn + hl * 8192;
#pragma unroll
    for (int cc = 0; cc < 4; ++cc) {
      int ch = half * 4 + cc;
      u32x4 v;
#pragma unroll
      for (int q = 0; q < 4; ++q) {
        int j0 = ch * 8 + 2 * q;
        v[q] = pack2(bf2f(lds16(ximg, j0, pp)) * sc_s[hl * 64 + j0], bf2f(lds16(ximg, j0 + 1, pp)) * sc_s[hl * 64 + j0 + 1]);
      }
      *(u32x4*)(XT + chunk_off(row, ch)) = v;
    }
    const int n = t & 63, qq = t >> 6;
#pragma unroll
    for (int cc = 0; cc < 2; ++cc) {
      int ch = qq * 2 + cc;
      u32x4 v;
#pragma unroll
      for (int q = 0; q < 4; ++q) v[q] = lds16(Bn, ch * 8 + 2 * q, n) | (lds16(Bn, ch * 8 + 2 * q + 1, n) << 16);
      *(u32x4*)(BT + chunk_off(n, ch)) = v;
    }
  }
  __syncthreads();
  {
    const int hl = w >> 1, pt = w & 1, hh = lane >> 5;
#pragma unroll
    for (int nt = 0; nt < 2; ++nt) {
      f32x16 acc = zero16();
      mma64(acc, XT, hl * 64 + pt * 32, BT, nt * 32, lane);
#pragma unroll
      for (int r = 0; r < 16; ++r) *(u16*)(Xn + hl * 8192 + img_off(pt * 32 + crow(r, hh), nt * 32 + (lane & 31))) = f2bf(acc[r]);
    }
  }
  if (c == 31) {
    for (int i = t; i < 3 * 192; i += 256) {
      int r = i / 192, q = i - r * 192;
      int ch = q < 128 ? grp * 256 + pair * 128 + q : (pair == 0 ? 512 : 640) + grp * 64 + (q - 128);
      p.out[O_CONVP + (size_t)(b * 3 + r) * 768 + ch] = bf2f(proj[(size_t)(61 + r) * NP + CX + ch]);
    }
  }
  __syncthreads();
  img2g(Xn, (u16*)(p.ws + OFF_X1 + 16777216) + (size_t)((b * 32 + c) * 8 + grp * 4 + pair * 2) * 4096, 64, 128);
  __syncthreads();
}

DI void p2a_gla_sample(const Params& p, int item, char* smem) {
  const int h = item & 3, s = item >> 2, tok = T_P + s;
  const int t = threadIdx.x, lane = t & 63, w = t >> 6;
  const u16* proj = (const u16*)(p.ws + OFF_PROJ) + (size_t)tok * NP;
  float* g_s = (float*)smem;
  float* q_s = g_s + 64;
  float* k_s = q_s + 64;
  float* v_s = k_s + 64;
  float* op_s = v_s + 128;
  float* red_s = op_s + 1024;
  if (t < 64) {
    float x = p.b_a2[h * 64 + t];
#pragma unroll
    for (int r = 0; r < 16; ++r) x += bf2f(proj[CAL + r]) * p.w_a2[r * 256 + h * 64 + t];
    g_s[t] = expf(logsig(x) * (1.f / 16.f));
    q_s[t] = bf2f(proj[CQ + h * 64 + t]) * 0.125f;
    k_s[t] = bf2f(proj[CK + h * 64 + t]);
  } else if (t < 192) v_s[t - 64] = bf2f(proj[CV + h * 128 + (t - 64)]);
  __syncthreads();
  const int e0 = (t & 31) * 4, dq = t >> 5;
  const float* S0 = p.st_gla + (size_t)(s * 4 + h) * 8192 + e0;
  float* So = p.out + O_GLAS + (size_t)(s * 4 + h) * 8192 + e0;
  const float4 ve = *(const float4*)(v_s + e0);
  float4 sv[8];
#pragma unroll
  for (int dd = 0; dd < 8; ++dd) sv[dd] = *(const float4*)(S0 + (size_t)(dq * 8 + dd) * 128);
  float4 op; op.x = 0.f; op.y = 0.f; op.z = 0.f; op.w = 0.f;
#pragma unroll
  for (int dd = 0; dd < 8; ++dd) {
    const int d = dq * 8 + dd;
    const float g = g_s[d], kd = k_s[d], qd = q_s[d];
    float4 sn;
    sn.x = g * sv[dd].x + kd * ve.x; sn.y = g * sv[dd].y + kd * ve.y; sn.z = g * sv[dd].z + kd * ve.z; sn.w = g * sv[dd].w + kd * ve.w;
    *(float4*)(So + (size_t)d * 128) = sn;
    op.x += qd * sn.x; op.y += qd * sn.y; op.z += qd * sn.z; op.w += qd * sn.w;
  }
  *(float4*)(op_s + dq * 128 + e0) = op;
  __syncthreads();
  float o = 0.f;
  if (t < 128) {
#pragma unroll
    for (int q = 0; q < 8; ++q) o += op_s[q * 128 + t];
  }
  float ss = red64(o * o);
  if (lane == 0) red_s[w] = ss;
  __syncthreads();
  if (t < 128) {
    float rs = rsqrtf((red_s[0] + red_s[1]) * (1.f / 128.f) + 1e-6f);
    float gg = bf2f(proj[CG + h * 128 + t]);
    u16* U = (u16*)(p.ws + OFF_X1) + (size_t)tok * 1024;
    U[h * 128 + t] = f2bf(o * rs * p.gla_ng[h * 128 + t] * silu(gg));
  }
  __syncthreads();
}

DI void p2a_gla_sample2(const Params& p, int pi, char* smem) {
  const int s = pi >> 1, h0 = (pi & 1) * 2, tok = T_P + s;
  const int t = threadIdx.x, lane = t & 63, w = t >> 6;
  const u16* proj = (const u16*)(p.ws + OFF_PROJ) + (size_t)tok * NP;
  float* g_s = (float*)smem;
  float* q_s = g_s + 128;
  float* k_s = q_s + 128;
  float* v_s = k_s + 128;
  float* op_s = v_s + 256;
  float* red_s = op_s + 2048;
  const int e0 = (t & 31) * 4, dq = t >> 5;
  float4 sv[2][8];
#pragma unroll
  for (int hh = 0; hh < 2; ++hh) {
    const float* S0 = p.st_gla + (size_t)(s * 4 + h0 + hh) * 8192 + e0;
#pragma unroll
    for (int dd = 0; dd < 8; ++dd) sv[hh][dd] = *(const float4*)(S0 + (size_t)(dq * 8 + dd) * 128);
  }
  if (t < 128) {
    const int hh = t >> 6, d = t & 63, h = h0 + hh;
    float x = p.b_a2[h * 64 + d];
#pragma unroll
    for (int r = 0; r < 16; ++r) x += bf2f(proj[CAL + r]) * p.w_a2[r * 256 + h * 64 + d];
    g_s[t] = expf(logsig(x) * (1.f / 16.f));
    q_s[t] = bf2f(proj[CQ + h * 64 + d]) * 0.125f;
    k_s[t] = bf2f(proj[CK + h * 64 + d]);
  }
  v_s[t] = bf2f(proj[CV + h0 * 128 + t]);
  __syncthreads();
#pragma unroll
  for (int hh = 0; hh < 2; ++hh) {
    float* So = p.out + O_GLAS + (size_t)(s * 4 + h0 + hh) * 8192 + e0;
    const float4 ve = *(const float4*)(v_s + hh * 128 + e0);
    float4 op; op.x = 0.f; op.y = 0.f; op.z = 0.f; op.w = 0.f;
#pragma unroll
    for (int dd = 0; dd < 8; ++dd) {
      const int d = dq * 8 + dd;
      const float g = g_s[hh * 64 + d], kd = k_s[hh * 64 + d], qd = q_s[hh * 64 + d];
      float4 sn;
      sn.x = g * sv[hh][dd].x + kd * ve.x; sn.y = g * sv[hh][dd].y + kd * ve.y; sn.z = g * sv[hh][dd].z + kd * ve.z; sn.w = g * sv[hh][dd].w + kd * ve.w;
      *(float4*)(So + (size_t)d * 128) = sn;
      op.x += qd * sn.x; op.y += qd * sn.y; op.z += qd * sn.z; op.w += qd * sn.w;
    }
    *(float4*)(op_s + (hh * 8 + dq) * 128 + e0) = op;
  }
  __syncthreads();
  const int hh = t >> 7, e = t & 127;
  float o = 0.f;
#pragma unroll
  for (int q = 0; q < 8; ++q) o += op_s[(hh * 8 + q) * 128 + e];
  float ss = red64(o * o);
  if (lane == 0) red_s[w] = ss;
  __syncthreads();
  {
    const float rs = rsqrtf((red_s[2 * hh] + red_s[2 * hh + 1]) * (1.f / 128.f) + 1e-6f);
    const int col = (h0 + hh) * 128 + e;
    const float gg = bf2f(proj[CG + col]);
    u16* U = (u16*)(p.ws + OFF_X1) + (size_t)tok * 1024;
    U[col] = f2bf(o * rs * p.gla_ng[col] * silu(gg));
  }
  __syncthreads();
}

DI void p2a_ssd_sample(const Params& p, int item, char* smem) {
  const int grp = item & 1, s = item >> 1, tok = T_P + s;
  const int t = threadIdx.x, lane = t & 63, w = t >> 6;
  const u16* proj = (const u16*)(p.ws + OFF_PROJ) + (size_t)tok * NP;
  float* x_s = (float*)smem;
  float* B_s = x_s + 256;
  float* C_s = B_s + 64;
  float* y_s = C_s + 64;
  float* red_s = y_s + 256;
  for (int i = t; i < 384; i += 256) {
    int ch = i < 256 ? grp * 256 + i : (i < 320 ? 512 + grp * 64 + (i - 256) : 640 + grp * 64 + (i - 320));
    const float* buf = p.st_conv + (size_t)s * 3 * 768;
    float b0 = buf[ch], b1 = buf[768 + ch], b2 = buf[1536 + ch], u = bf2f(proj[CX + ch]);
    float sv = p.conv_b[ch] + b0 * p.conv_w[ch] + b1 * p.conv_w[768 + ch] + b2 * p.conv_w[1536 + ch] + u * p.conv_w[2304 + ch];
    x_s[i] = silu(sv);
    float* co = p.out + O_CONVS + (size_t)s * 3 * 768;
    co[ch] = b1; co[768 + ch] = b2; co[1536 + ch] = u;
  }
  __syncthreads();
  const int pp = t >> 2, nq = t & 3;
  float ssq = 0.f;
#pragma unroll
  for (int hl = 0; hl < 4; ++hl) {
    int hd = grp * 4 + hl;
    float dt = softplus(bf2f(proj[CDT + hd]) + p.dt_bias[hd]);
    float dA = expf(-expf(p.a_log[hd]) * dt);
    float xv = x_s[hl * 64 + pp];
    const float4* h0 = (const float4*)(p.st_ssm + (size_t)((s * 8 + hd) * 64 + pp) * 64 + nq * 16);
    float4* ho = (float4*)(p.out + O_SSMS + (size_t)((s * 8 + hd) * 64 + pp) * 64 + nq * 16);
    float yp = 0.f, dx = dt * xv;
#pragma unroll
    for (int q = 0; q < 4; ++q) {
      float4 hv = h0[q];
      int n = nq * 16 + q * 4;
      hv.x = dA * hv.x + dx * B_s[n]; hv.y = dA * hv.y + dx * B_s[n + 1]; hv.z = dA * hv.z + dx * B_s[n + 2]; hv.w = dA * hv.w + dx * B_s[n + 3];
      ho[q] = hv;
      yp += hv.x * C_s[n] + hv.y * C_s[n + 1] + hv.z * C_s[n + 2] + hv.w * C_s[n + 3];
    }
    yp += __shfl_xor(yp, 1);
    yp += __shfl_xor(yp, 2);
    float z = bf2f(proj[CZ + grp * 256 + hl * 64 + pp]);
    float y = (yp + p.d_skip[hd] * xv) * silu(z);
    if (nq == 0) { y_s[hl * 64 + pp] = y; ssq += y * y; }
  }
  ssq = red64(ssq);
  if (lane == 0) red_s[w] = ssq;
  __syncthreads();
  {
    float rs = rsqrtf((red_s[0] + red_s[1] + red_s[2] + red_s[3]) * (1.f / 256.f) + 1e-6f);
    u16* U = (u16*)(p.ws + OFF_X1) + (size_t)tok * 1024;
    U[512 + grp * 256 + t] = f2bf(y_s[t] * rs * p.ssd_ng[grp * 256 + t]);
  }
  __syncthreads();
}

DI void p2b_item(const Params& p, int item) {
  const int t = threadIdx.x;
  if (item < 256) {
    const int gid = item * 256 + t;
    const int dq = gid & 15, e = (gid >> 4) & 127, h = (gid >> 11) & 3, b = gid >> 13;
    const u16* dS = (const u16*)(p.ws + OFF_X1);
    u16* Sp = (u16*)(p.ws + OFF_X2);
    const float* gg = (const float*)(p.ws + OFF_GG);
    float S0 = 0.f, S1 = 0.f, S2 = 0.f, S3 = 0.f;
#pragma unroll 16
    for (int c = 0; c < 32; ++c) {
      const size_t base = ((size_t)((b * 32 + c) * 4 + h) * 128 + e) * 64 + dq * 4;
      uint2 o; o.x = pack2(S0, S1); o.y = pack2(S2, S3);
      *(uint2*)(Sp + base) = o;
      const uint2 ds = *(const uint2*)(dS + base);
      const float4 g = *(const float4*)(gg + ((b * 32 + c) * 4 + h) * 64 + dq * 4);
      S0 = g.x * S0 + bflo(ds.x);
      S1 = g.y * S1 + bfhi(ds.x);
      S2 = g.z * S2 + bflo(ds.y);
      S3 = g.w * S3 + bfhi(ds.y);
    }
    float* o = p.out + O_GLAP + (size_t)((b * 4 + h) * 64 + dq * 4) * 128 + e;
    o[0] = S0; o[128] = S1; o[256] = S2; o[384] = S3;
  } else {
    const int gid = (item - 256) * 256 + t;
    const int nq = gid & 15, pp = (gid >> 4) & 63, hd = (gid >> 10) & 7, b = gid >> 13;
    const u16* dh = (const u16*)(p.ws + OFF_X1 + 16777216);
    u16* hp = (u16*)(p.ws + OFF_X2 + 16777216);
    const float* gs = (const float*)(p.ws + OFF_GS);
    float h0 = 0.f, h1 = 0.f, h2 = 0.f, h3 = 0.f;
#pragma unroll 16
    for (int c = 0; c < 32; ++c) {
      const size_t base = ((size_t)((b * 32 + c) * 8 + hd) * 64 + pp) * 64 + nq * 4;
      uint2 o; o.x = pack2(h0, h1); o.y = pack2(h2, h3);
      *(uint2*)(hp + base) = o;
      const uint2 dv = *(const uint2*)(dh + base);
      const float g = gs[(b * 32 + c) * 8 + hd];
      h0 = g * h0 + bflo(dv.x);
      h1 = g * h1 + bfhi(dv.x);
      h2 = g * h2 + bflo(dv.y);
      h3 = g * h3 + bfhi(dv.y);
    }
    float4 r; r.x = h0; r.y = h1; r.z = h2; r.w = h3;
    *(float4*)(p.out + O_SSMP + (size_t)((b * 8 + hd) * 64 + pp) * 64 + nq * 4) = r;
  }
}

struct GlcPre { u32x4 q0, q1, k0, k1, vt0, vt1, vt2, vt3, g0, g1, g2, g3; bf16x8 sf[4]; };
DI void p2c_gla_load(const Params& p, int item, GlcPre& R) {
  const int h = item & 3, c = (item >> 2) & 31, b = item >> 7;
  const int t = threadIdx.x, lane = t & 63, w = t >> 6, hh = lane >> 5, pr = t >> 3, pch = t & 7;
  const int tok0 = b * 2048 + c * 64;
  const u16* qk = (const u16*)((const char*)p.out + OUTB_QK) + (size_t)(tok0 + pr) * 512 + pch * 8;
  const u16* gp = (const u16*)(p.ws + OFF_PROJ) + (size_t)(tok0 + pr) * NP + CG + h * 128 + pch * 8;
  R.q0 = *(const u32x4*)(qk + h * 64); R.q1 = *(const u32x4*)(qk + (size_t)32 * 512 + h * 64);
  R.k0 = *(const u32x4*)(qk + 256 + h * 64); R.k1 = *(const u32x4*)(qk + (size_t)32 * 512 + 256 + h * 64);
  const u16* vp = (const u16*)(p.ws + OFF_PROJ) + (size_t)(tok0 + pr) * NP + CV + h * 128 + pch * 8;
  R.vt0 = *(const u32x4*)vp; R.vt1 = *(const u32x4*)(vp + (size_t)32 * NP); R.vt2 = *(const u32x4*)(vp + 64); R.vt3 = *(const u32x4*)(vp + (size_t)32 * NP + 64);
  R.g0 = *(const u32x4*)gp; R.g1 = *(const u32x4*)(gp + (size_t)32 * NP); R.g2 = *(const u32x4*)(gp + 64); R.g3 = *(const u32x4*)(gp + (size_t)32 * NP + 64);
  const u16* Sp = (const u16*)(p.ws + OFF_X2) + (size_t)((b * 32 + c) * 4 + h) * 8192;
#pragma unroll
  for (int ks = 0; ks < 4; ++ks) R.sf[ks] = *(const bf16x8*)(Sp + (w * 32 + (lane & 31)) * 64 + (ks * 2 + hh) * 8);
}

DI void p2c_gla(const Params& p, int item, int next_item, char* smem, GlcPre& R) {
  const int h = item & 3, c = (item >> 2) & 31, b = item >> 7;
  const int t = threadIdx.x, lane = t & 63, w = t >> 6, hh = lane >> 5;
  const int tok0 = b * 2048 + c * 64;
  const u16* proj = (const u16*)(p.ws + OFF_PROJ) + (size_t)tok0 * NP;
  const u16* qk = (const u16*)((const char*)p.out + OUTB_QK) + (size_t)tok0 * 512;
  const u16* vtg = (const u16*)((const char*)p.out + OUTB_VT) + (size_t)item * 8192;
  char* Q = smem;
  char* Kt = smem + 8192;
  char* VT = smem + 16384;
  char* Aimg = smem + 32768;
  char* Gn = smem + 40960;
  float* part_s = (float*)(smem + 57344);
  bf16x8 sfrag[4];
  {
    const int pr = t >> 3, pch = t & 7;
    *(u32x4*)(Q + chunk_off(pr, pch)) = R.q0; *(u32x4*)(Q + chunk_off(pr + 32, pch)) = R.q1;
    *(u32x4*)(Kt + chunk_off(pr, pch)) = R.k0; *(u32x4*)(Kt + chunk_off(pr + 32, pch)) = R.k1;
    *(u32x4*)(VT + chunk_off(pr, pch)) = R.vt0; *(u32x4*)(VT + chunk_off(pr + 32, pch)) = R.vt1;
    *(u32x4*)(VT + 8192 + chunk_off(pr, pch)) = R.vt2; *(u32x4*)(VT + 8192 + chunk_off(pr + 32, pch)) = R.vt3;
    *(u32x4*)(Gn + chunk_off(pr, pch)) = R.g0; *(u32x4*)(Gn + chunk_off(pr + 32, pch)) = R.g1;
    *(u32x4*)(Gn + 8192 + chunk_off(pr, pch)) = R.g2; *(u32x4*)(Gn + 8192 + chunk_off(pr + 32, pch)) = R.g3;
#pragma unroll
    for (int ks = 0; ks < 4; ++ks) sfrag[ks] = R.sf[ks];
    if (next_item < 1024) p2c_gla_load(p, next_item, R);
  }
  __syncthreads();
  {
    const int it = w >> 1, jt = w & 1;
    f32x16 a = zero16();
    mma64(a, Q, it * 32, Kt, jt * 32, lane);
#pragma unroll
    for (int r = 0; r < 16; ++r) {
      int i = it * 32 + crow(r, hh), j = jt * 32 + (lane & 31);
      *(u16*)(Aimg + img_off(i, j)) = f2bf(i >= j ? a[r] : 0.f);
    }
  }
  __syncthreads();
  f32x16 acc[2];
  bf16x8 vfr[4];
  tr_frags4(VT + (w >> 1) * 8192, (w & 1) * 32, lane, vfr);
#pragma unroll
  for (int it = 0; it < 2; ++it) {
    acc[it] = zero16();
#pragma unroll
    for (int ks = 0; ks < 4; ++ks) {
      acc[it] = MFMA(frag(Aimg, it * 32, ks, lane), vfr[ks], acc[it]);
      acc[it] = MFMA(frag(Q, it * 32, ks, lane), sfrag[ks], acc[it]);
    }
#pragma unroll
    for (int r = 0; r < 16; ++r) {
      float ss = red32(acc[it][r] * acc[it][r]);
      if ((lane & 31) == 0) part_s[w * 64 + it * 32 + crow(r, hh)] = ss;
    }
  }
  __syncthreads();
  const int e = w * 32 + (lane & 31);
  const float gn = p.gla_ng[h * 128 + e];
  char* gimg = Gn + (w >> 1) * 8192;
  const int ec = (w & 1) * 32 + (lane & 31);
#pragma unroll
  for (int it = 0; it < 2; ++it)
#pragma unroll
    for (int r = 0; r < 16; ++r) {
      int i = it * 32 + crow(r, hh);
      float rs = rsqrtf((part_s[i] + part_s[64 + i] + part_s[128 + i] + part_s[192 + i]) * (1.f / 128.f) + 1e-6f);
      u16* gp = (u16*)(gimg + img_off(i, ec));
      *gp = f2bf(acc[it][r] * rs * gn * silu(bf2f(*gp)));
    }
  __syncthreads();
  u16* U = (u16*)(p.ws + OFF_X1) + (size_t)tok0 * 1024 + h * 128;
  img2g(Gn, U, 1024, 64);
  img2g(Gn + 8192, U + 64, 1024, 64);
  __syncthreads();
}

DI void p2c_ssd(const Params& p, int item, char* smem) {
  const int grp = item & 1, c = (item >> 1) & 31, b = item >> 6;
  const int t = threadIdx.x, lane = t & 63, w = t >> 6, hh = lane >> 5;
  const int tok0 = b * 2048 + c * 64;
  const u16* proj = (const u16*)(p.ws + OFF_PROJ) + (size_t)tok0 * NP;
  const u16* xbcc = (const u16*)((const char*)p.out + OUTB_XBCC) + (size_t)tok0 * 768;
  u16* U = (u16*)(p.ws + OFF_X1) + (size_t)tok0 * 1024 + 512 + grp * 256;
  char* Cimg = smem;
  char* Bimg = smem + 8192;
  char* Xn = smem + 16384;
  char* Ximg = smem + 24576;
  char* Simg = smem + 32768;
  char* Zn = smem + 40960;
  float* cum_s = (float*)(smem + 49152);
  float* dt_s = cum_s + 256;
  float* part_s = dt_s + 256;
  g2img(xbcc + 640 + grp * 64, 768, Cimg, 64);
  g2img(xbcc + 512 + grp * 64, 768, Bimg, 64);
  cum_s[t] = ((const float*)(p.ws + OFF_CUM))[(size_t)(tok0 + (t & 63)) * 8 + grp * 4 + (t >> 6)];
  dt_s[t] = ((const float*)(p.ws + OFF_DT))[(size_t)(tok0 + (t & 63)) * 8 + grp * 4 + (t >> 6)];
  __syncthreads();
  const int it = w >> 1, pt = w & 1;
  f32x16 cb = zero16();
  mma64(cb, Cimg, it * 32, Bimg, pt * 32, lane);
  f32x16 ssq = zero16();
  const int pr = t >> 3, pch = t & 7;
  u32x4 xr0, xr1, zr0, zr1;
  bf16x8 hfn[4];
#define LOADH(hl_) do { \
    const u16* xs_ = xbcc + grp * 256 + (hl_) * 64 + (size_t)pr * 768 + pch * 8; \
    const u16* zs_ = proj + CZ + grp * 256 + (hl_) * 64 + (size_t)pr * NP + pch * 8; \
    xr0 = *(const u32x4*)xs_; xr1 = *(const u32x4*)(xs_ + (size_t)32 * 768); \
    zr0 = *(const u32x4*)zs_; zr1 = *(const u32x4*)(zs_ + (size_t)32 * NP); \
    const u16* hp_ = (const u16*)(p.ws + OFF_X2 + 16777216) + (size_t)((b * 32 + c) * 8 + grp * 4 + (hl_)) * 4096; \
    _Pragma("unroll") for (int ks = 0; ks < 4; ++ks) hfn[ks] = *(const bf16x8*)(hp_ + (pt * 32 + (lane & 31)) * 64 + (ks * 2 + hh) * 8); } while (0)
  LOADH(0);
#pragma unroll 1
  for (int hl = 0; hl < 4; ++hl) {
    const int hd = grp * 4 + hl;
    *(u32x4*)(Xn + chunk_off(pr, pch)) = xr0; *(u32x4*)(Xn + chunk_off(pr + 32, pch)) = xr1;
    *(u32x4*)(Zn + chunk_off(pr, pch)) = zr0; *(u32x4*)(Zn + chunk_off(pr + 32, pch)) = zr1;
    bf16x8 hf[4];
#pragma unroll
    for (int ks = 0; ks < 4; ++ks) hf[ks] = hfn[ks];
    if (hl < 3) LOADH(hl + 1);
#pragma unroll
    for (int r = 0; r < 16; ++r) {
      int i = it * 32 + crow(r, hh), j = pt * 32 + (lane & 31);
      float sv = i >= j ? cb[r] * __expf(cum_s[hl * 64 + i] - cum_s[hl * 64 + j]) : 0.f;
      *(u16*)(Simg + img_off(i, j)) = f2bf(sv);
    }
    __syncthreads();
    {
      const int pp = t & 63, qq = t >> 6;
#pragma unroll
      for (int cc = 0; cc < 2; ++cc) {
        int ch = qq * 2 + cc;
        u32x4 v;
#pragma unroll
        for (int q = 0; q < 4; ++q) {
          int j0 = ch * 8 + 2 * q;
          v[q] = pack2(bf2f(lds16(Xn, j0, pp)) * dt_s[hl * 64 + j0], bf2f(lds16(Xn, j0 + 1, pp)) * dt_s[hl * 64 + j0 + 1]);
        }
        *(u32x4*)(Ximg + chunk_off(pp, ch)) = v;
      }
    }
    __syncthreads();
    f32x16 y = zero16();
#pragma unroll
    for (int ks = 0; ks < 4; ++ks) y = MFMA(frag(Cimg, it * 32, ks, lane), hf[ks], y);
#pragma unroll
    for (int r = 0; r < 16; ++r) y[r] *= __expf(cum_s[hl * 64 + it * 32 + crow(r, hh)]);
    mma64(y, Simg, it * 32, Ximg, pt * 32, lane);
    const float dsk = p.d_skip[hd];
    const int pc = pt * 32 + (lane & 31);
#pragma unroll
    for (int r = 0; r < 16; ++r) {
      int i = it * 32 + crow(r, hh);
      float xs = bf2f(lds16(Xn, i, pc));
      u16* zp = (u16*)(Zn + img_off(i, pc));
      u16 yb = f2bf((y[r] + dsk * xs) * silu(bf2f(*zp)));
      *zp = yb;
      float yo = bf2f(yb);
      ssq[r] += yo * yo;
    }
    __syncthreads();
    img2g(Zn, U + hl * 64, 1024, 64);
    __syncthreads();
  }
#undef LOADH
#pragma unroll
  for (int r = 0; r < 16; ++r) {
    float ss = red32(ssq[r]);
    if ((lane & 31) == 0) part_s[pt * 64 + it * 32 + crow(r, hh)] = ss;
  }
  __syncthreads();
  {
    const int r = t >> 3, ch = t & 7;
    u32x4 uv[4][2];
    float4 ga[4], gb[4];
#pragma unroll
    for (int hl = 0; hl < 4; ++hl) {
      ga[hl] = *(const float4*)(p.ssd_ng + grp * 256 + hl * 64 + ch * 8);
      gb[hl] = *(const float4*)(p.ssd_ng + grp * 256 + hl * 64 + ch * 8 + 4);
#pragma unroll
      for (int i2 = 0; i2 < 2; ++i2) uv[hl][i2] = *(const u32x4*)(U + (size_t)(r + 32 * i2) * 1024 + hl * 64 + ch * 8);
    }
    const float rs0 = rsqrtf((part_s[r] + part_s[64 + r]) * (1.f / 256.f) + 1e-6f);
    const float rs1 = rsqrtf((part_s[r + 32] + part_s[64 + r + 32]) * (1.f / 256.f) + 1e-6f);
#pragma unroll
    for (int hl = 0; hl < 4; ++hl)
#pragma unroll
      for (int i2 = 0; i2 < 2; ++i2) {
        const float rs = i2 ? rs1 : rs0;
        u32x4 v = uv[hl][i2];
        v[0] = pack2(bflo(v[0]) * rs * ga[hl].x, bfhi(v[0]) * rs * ga[hl].y);
        v[1] = pack2(bflo(v[1]) * rs * ga[hl].z, bfhi(v[1]) * rs * ga[hl].w);
        v[2] = pack2(bflo(v[2]) * rs * gb[hl].x, bfhi(v[2]) * rs * gb[hl].y);
        v[3] = pack2(bflo(v[3]) * rs * gb[hl].z, bfhi(v[3]) * rs * gb[hl].w);
        *(u32x4*)(U + (size_t)(r + 32 * i2) * 1024 + hl * 64 + ch * 8) = v;
      }
  }
  __syncthreads();
}

#define XB_TMO      128
#define XB_XCNT(j)  (256  + 64 * (j))
#define XB_XSUB(j)  (1280 + 64 * (j))
#define XB_XGEN(j)  (2304 + 64 * (j))
#define XB_TOP      3328
#define XB_TOPGEN   3392
#define XCD_BAR_WORDS 3456
#define XB_SPIN_CAP (1u << 20)
#define LAS __attribute__((address_space(3)))
DI unsigned xb_ld(unsigned* p) { return __hip_atomic_load(p, __ATOMIC_RELAXED, __HIP_MEMORY_SCOPE_AGENT); }
DI unsigned xb_add(unsigned* p, unsigned v) { return __hip_atomic_fetch_add(p, v, __ATOMIC_RELAXED, __HIP_MEMORY_SCOPE_AGENT); }
DI unsigned xb_xcc_id() { return (unsigned)__builtin_amdgcn_s_getreg((3 << 11) | 20) & 0xFu; }
#define XB_SPIN(cond, bar) do { unsigned _sp = 0; while (cond) { __builtin_amdgcn_s_sleep(1); \
    if ((++_sp & 255u) == 0u) { if (xb_ld(&(bar)[XB_TMO])) break; if (_sp > XB_SPIN_CAP) { atomicAdd(&(bar)[XB_TMO], 1u); break; } } } } while (0)
struct XcdBarrier { unsigned* bar; unsigned x; volatile LAS unsigned* st; };
DI XcdBarrier xcd_barrier_post(unsigned* bar, volatile LAS unsigned* st) {
  XcdBarrier b; b.bar = bar; b.x = xb_xcc_id(); b.st = st;
  if (threadIdx.x == 0) (void)xb_add(&bar[XB_XCNT(b.x)], 1u);
  return b;
}
DI void xcd_barrier_complete(unsigned* bar, unsigned x, unsigned& nloc, unsigned& nx) {
  const unsigned G = gridDim.x * gridDim.y * gridDim.z;
  unsigned sum, cnt, mine, sp = 0u;
  for (;;) {
    sum = 0u; cnt = 0u; mine = 0u;
#pragma unroll
    for (unsigned j = 0; j < 16; ++j) { const unsigned c = xb_ld(&bar[XB_XCNT(j)]); sum += c; cnt += (c > 0u) ? 1u : 0u; mine = (j == x) ? c : mine; }
    if (sum == G) break;
    __builtin_amdgcn_s_sleep(1);
    if ((++sp & 255u) == 0u) { if (xb_ld(&bar[XB_TMO])) break; if (sp > XB_SPIN_CAP) { atomicAdd(&bar[XB_TMO], 1u); break; } }
  }
  nloc = mine > 0u ? mine : 1u; nx = cnt > 0u ? cnt : 1u;
}
DI void xcd_barrier(const XcdBarrier& b) {
  asm volatile("s_waitcnt vmcnt(0)" ::: "memory");
  __syncthreads();
  if (threadIdx.x == 0) {
    unsigned* bar = b.bar;
    __builtin_amdgcn_s_waitcnt(0);
    unsigned nloc = b.st[0], nx = b.st[1];
    if (nloc == 0u) { xcd_barrier_complete(bar, b.x, nloc, nx); b.st[0] = nloc; b.st[1] = nx; }
    const unsigned old = xb_add(&bar[XB_XSUB(b.x)], 1u);
    const unsigned gen = old / nloc;
    if (old + 1u == (gen + 1u) * nloc) {
      __builtin_amdgcn_fence(__ATOMIC_RELEASE, "agent");
      asm volatile("s_waitcnt vmcnt(0)" ::: "memory");
      const unsigned og = xb_add(&bar[XB_TOP], 1u);
      const unsigned tg = og / nx;
      if (og + 1u == (tg + 1u) * nx) xb_add(&bar[XB_TOPGEN], 1u);
      else XB_SPIN(xb_ld(&bar[XB_TOPGEN]) == tg, bar);
      __builtin_amdgcn_fence(__ATOMIC_ACQUIRE, "agent");
      xb_add(&bar[XB_XGEN(b.x)], 1u);
      asm volatile("s_waitcnt vmcnt(0)" ::: "memory");
    } else {
      XB_SPIN(xb_ld(&bar[XB_XGEN(b.x)]) == gen, bar);
      __builtin_amdgcn_fence(__ATOMIC_ACQUIRE, "agent");
      asm volatile("s_waitcnt vmcnt(0)" ::: "memory");
    }
  }
  __syncthreads();
}

constexpr int N_PHASES = 7;
__host__ __device__ constexpr int phase_items(int ph) {
  return ph == 0 ? 2064 + 1760 : ph == 1 ? 5031 : ph == 2 ? 1024 : ph == 3 ? 512 : ph == 4 ? 1024 : ph == 5 ? 1024
         : ph == 6 ? 1024 : 4128;
}

#if MK_MULTI
#define GRID_SYNC(PH)
#else
#define GRID_SYNC(PH) if (PH < p.ph_hi) xcd_barrier(xb);
#endif
#define ITEMS(LO, HI, SHIFT, BODY) \
  for (int item = (LO) + (int)((blockIdx.x + (SHIFT)) % gridDim.x); item < (HI); item += gridDim.x) { BODY; }
#ifndef PROBE_REP
#define PROBE_REP(X)
#endif

__global__ void __launch_bounds__(256, 2) mega(Params p) {
  __shared__ __attribute__((aligned(16))) char smem[65536 + 1024];
#if !MK_MULTI
  __shared__ uint4 xb_words;
  if (threadIdx.x == 0) xb_words = make_uint4(0u, 0u, 0u, 0u);
  __syncthreads();
  XcdBarrier xb = xcd_barrier_post((unsigned*)(p.ws + OFF_BAR), (volatile LAS unsigned*)&xb_words);
  if (p.ph_lo > p.ph_hi) cg::this_grid().sync();
#endif
  if (p.ph_lo <= 0 && 0 <= p.ph_hi) {
    ITEMS(0, 2064 + 1760, 0, p0_item(p, item, smem))
    GRID_SYNC(0)
  }
  if (p.ph_lo <= 1 && 1 <= p.ph_hi) {
    ITEMS(0, 5031, 0, p1_tile(p, item, smem))
    GRID_SYNC(1)
  }
  if (p.ph_lo <= 2 && 2 <= p.ph_hi) {
    {
      GlaPre R;
      int item = blockIdx.x;
      if (item < 1024) p2a_gla_load(p, item, R);
      for (; item < 1024; item += gridDim.x) p2a_gla(p, item, item + (int)gridDim.x, smem, R);
    }
    ITEMS(0, 1024, 0, p2a_ssd(p, item, smem))
    ITEMS(0, 256, 0, p2a_gla_sample2(p, item, smem))
    ITEMS(0, 256, 256, p2a_ssd_sample(p, item, smem))
    GRID_SYNC(2)
  }
  if (p.ph_lo <= 3 && 3 <= p.ph_hi) {
    ITEMS(0, 512, 0, p2b_item(p, item))
    GRID_SYNC(3)
  }
  if (p.ph_lo <= 4 && 4 <= p.ph_hi) {
    ITEMS(0, 128, 0, p3_sample(p, item, smem))
    {
      GlcPre R;
      int item = blockIdx.x;
      if (item < 1024) p2c_gla_load(p, item, R);
      for (; item < 1024; item += gridDim.x) p2c_gla(p, item, item + (int)gridDim.x, smem, R);
    }
    ITEMS(0, 512, 0, p2c_ssd(p, item, smem))
    GRID_SYNC(4)
  }
  if (p.ph_lo <= 5 && 5 <= p.ph_hi) {
    ITEMS(0, 128, 0, p4_sample(p, item, smem))
    ITEMS(0, 1024, 0, p3_tile(p, item, smem))
    GRID_SYNC(5)
  }
  if (p.ph_lo <= 6 && 6 <= p.ph_hi) {
    ITEMS(0, 32, 0, p5_item(p, item, p.out + O_YS))
    ITEMS(0, 1024, 0, p4_tile(p, item, smem))
  }
#ifdef PROBE_P5
  if (p.ph_lo == 8) { ITEMS(0, 4128, 0, p5_item(p, item, (float*)(p.ws + OFF_PROJ))) }
#endif
}

extern "C" void kernel_launch(void* const* d_in, const int* in_sizes, int n_in, void* d_out, int out_size, void* d_ws, size_t ws_size,
                              hipStream_t stream) {
  (void)in_sizes; (void)n_in; (void)out_size;
  if (ws_size < WS_NEED) fprintf(stderr, "kernel_launch: workspace too small (%zu < %zu)\n", ws_size, WS_NEED);
  Params p{};
  const float** f = (const float**)&p;
  for (int i = 0; i < 20; ++i) f[i] = (const float*)d_in[i];
  p.out = (float*)d_out;
  p.ws = (char*)d_ws;
  hipMemsetAsync((char*)d_ws + OFF_BAR, 0, XCD_BAR_WORDS * 4 + 1024, stream);
#if MK_MULTI
  for (int ph = 0; ph < N_PHASES; ++ph) {
    p.ph_lo = ph; p.ph_hi = ph;
    hipLaunchKernelGGL(mega, dim3(phase_items(ph)), dim3(256), 0, stream, p);
#ifdef PROBE_P5
    if (ph == 7) { p.ph_lo = 8; p.ph_hi = 8; for (int rep = 0; rep < 2; ++rep) hipLaunchKernelGGL(mega, dim3(4128), dim3(256), 0, stream, p); }
#endif
#ifdef PROBE_REP_PH
    if (ph == PROBE_REP_PH) for (int rep = 0; rep < 2; ++rep) hipLaunchKernelGGL(mega, dim3(phase_items(ph)), dim3(256), 0, stream, p);
#endif
  }
#else
  static int grid_blocks = 0;
  if (!grid_blocks) {
    int dev = 0, cus = 0, per_cu = 0;
    hipGetDevice(&dev);
    hipDeviceGetAttribute(&cus, hipDeviceAttributeMultiprocessorCount, dev);
    hipOccupancyMaxActiveBlocksPerMultiprocessor(&per_cu, mega, 256, 0);
    if (per_cu < 1) per_cu = 1;
    if (per_cu > 2) per_cu = 2;
    grid_blocks = (cus * per_cu) & ~63;
  }
  p.ph_lo = 0; p.ph_hi = N_PHASES - 1;
  void* args[] = {&p};
  hipError_t e = hipLaunchCooperativeKernel((void*)mega, dim3(grid_blocks), dim3(256), args, 0, stream);
  if (e != hipSuccess) fprintf(stderr, "cooperative launch failed: %s (grid %d)\n", hipGetErrorString(e), grid_blocks);
#endif
}
```
